# Optimizing an MI355X kernel written in HIP

```python
import math
import jax, jax.numpy as jnp
from jax import lax
import numpy as np

D_MODEL = 4096
BATCH = 2
SEQ = 4096
DEPTH = 2

N_META = 16
Q_BLOCK = 128
LEAD = Q_BLOCK
N_PAD = LEAD - N_META
RMS_EPS = 1e-6
NEG_INF = -1e30

MLA_V = 128
MLA_HEADS = (3 * D_MODEL // 8) // MLA_V
MLA_NOPE = 128
MLA_ROPE = 64
MLA_Q_LORA = 1536
MLA_KV_LORA = 512
ROPE_THETA = 10000.0

GLA_DV = 256
GLA_DK = 128
GLA_HEADS = (D_MODEL // 4) // GLA_DV
GLA_GATE_RANK = 16
GLA_TAU = 16.0
GLA_CHUNK = 64

FOX_DH = 128
FOX_HEADS = (3 * D_MODEL // 8) // FOX_DH

W_MLA = MLA_HEADS * MLA_V
W_GLA = GLA_HEADS * GLA_DV
W_FOX = FOX_HEADS * FOX_DH
D_MIX = W_MLA + W_GLA + W_FOX

IN_SIZES = (
    MLA_Q_LORA, MLA_KV_LORA, MLA_ROPE,
    GLA_HEADS * GLA_DK, GLA_HEADS * GLA_DK, W_GLA,
    GLA_GATE_RANK, W_GLA,
    W_FOX, W_FOX, W_FOX, FOX_HEADS,
)
D_IN = sum(IN_SIZES)

D_FF = 256 * (-(-8 * D_MODEL // (3 * 256)))
CONV_W = 3

kernel_name = "hybrid_mla_gla_fox_convffn"


def rms_norm(x, g):
    xf = x.astype(jnp.float32)
    y = xf * lax.rsqrt(jnp.mean(xf * xf, axis=-1, keepdims=True) + RMS_EPS)
    return (y * g.astype(jnp.float32)).astype(x.dtype)


def head_rms_norm(o, gain, n_heads):
    b, l = o.shape[:2]
    o = o.reshape(b, l, n_heads, -1)
    return rms_norm(o, gain.reshape(n_heads, -1)).reshape(b, l, -1)


def split_cols(x, sizes):
    out, start = [], 0
    for s in sizes:
        out.append(x[..., start:start + s])
        start += s
    return out


def rope(x, cos, sin):
    half = x.shape[-1] // 2
    x1, x2 = x[..., :half], x[..., half:]
    xf1, xf2 = x1.astype(jnp.float32), x2.astype(jnp.float32)
    return jnp.concatenate([xf1 * cos - xf2 * sin, xf2 * cos + xf1 * sin], axis=-1).astype(x.dtype)


def causal_block_attention(q, k, v, key_valid, scale, log_f_cum=None):
    L = q.shape[1]
    outs = []
    for i in range(L // Q_BLOCK):
        q0 = i * Q_BLOCK
        k_end = q0 + Q_BLOCK
        qb = q[:, q0:k_end].astype(jnp.float32)
        kb = k[:, :k_end].astype(jnp.float32)
        vb = v[:, :k_end].astype(jnp.float32)
        s = jnp.einsum('bqhd,bkhd->bhqk', qb, kb) * scale
        if log_f_cum is not None:
            c_q = jnp.transpose(log_f_cum[:, q0:k_end], (0, 2, 1))[..., :, None]
            c_k = jnp.transpose(log_f_cum[:, :k_end], (0, 2, 1))[..., None, :]
            s = s + (c_q - c_k)
        q_pos = q0 + jnp.arange(Q_BLOCK)
        k_pos = jnp.arange(k_end)
        mask = (k_pos[None, :] <= q_pos[:, None]) & key_valid[None, :k_end]
        s = jnp.where(mask, s, NEG_INF)
        p = jax.nn.softmax(s, axis=-1)
        outs.append(jnp.einsum('bhqk,bkhd->bqhd', p, vb).astype(v.dtype))
    return jnp.concatenate(outs, axis=1)


def gla_chunked(q, k, v, log_a):
    B, L, H, DK = q.shape
    DV = v.shape[-1]
    C = GLA_CHUNK
    N = L // C
    q = q.reshape(B, N, C, H, DK)
    k = k.reshape(B, N, C, H, DK)
    v = v.reshape(B, N, C, H, DV)
    log_a = log_a.reshape(B, N, C, H, DK)
    b = jnp.cumsum(log_a, axis=2)
    b_last = b[:, :, -1:]
    q_dec = q * jnp.exp(b)
    k_dec = k * jnp.exp(-b)
    causal = jnp.tril(jnp.ones((C, C), dtype=bool))
    a = jnp.einsum('bnthk,bnshk->bnhts', q_dec, k_dec)
    a = jnp.where(causal, a, 0.0)
    o_intra = jnp.einsum('bnhts,bnshv->bnthv', a, v)
    k_state = k * jnp.exp(b_last - b)
    decay = jnp.exp(b_last[:, :, 0])

    def step(state, inp):
        q_c, k_c, v_c, d_c = inp
        o_c = jnp.einsum('bthk,bhkv->bthv', q_c, state)
        state = state * d_c[..., None] + jnp.einsum('bthk,bthv->bhkv', k_c, v_c)
        return state, o_c

    xs = (jnp.moveaxis(q_dec, 1, 0), jnp.moveaxis(k_state, 1, 0),
          jnp.moveaxis(v, 1, 0), jnp.moveaxis(decay, 1, 0))
    s0 = jnp.zeros((B, H, DK, DV), jnp.float32)
    _, o_inter = lax.scan(step, s0, xs)
    o = o_intra + jnp.moveaxis(o_inter, 0, 1)
    return o.reshape(B, L, H, DV)


def hybrid_mixer(hn, valid, cos, sin, w_in, mla_q_norm, mla_w_uq, mla_kv_norm, mla_w_ukv,
                 gla_w_gate2, gla_b_gate, fox_b_f, out_norm_mla, out_norm_gla,
                 out_norm_fox, w_out):
    B, L, _ = hn.shape
    proj = hn @ w_in
    (c_q, c_kv, k_rope, g_q, g_k, g_v, g_z, g_r,
     f_q, f_k, f_v, f_z) = split_cols(proj, IN_SIZES)

    q = (rms_norm(c_q, mla_q_norm) @ mla_w_uq).reshape(B, L, MLA_HEADS, MLA_NOPE + MLA_ROPE)
    q_nope, q_pe = q[..., :MLA_NOPE], q[..., MLA_NOPE:]
    q_pe = rope(q_pe, cos[:, None, :], sin[:, None, :])
    kv = (rms_norm(c_kv, mla_kv_norm) @ mla_w_ukv).reshape(B, L, MLA_HEADS, MLA_NOPE + MLA_V)
    k_nope, v_m = kv[..., :MLA_NOPE], kv[..., MLA_NOPE:]
    k_pe = rope(k_rope, cos, sin)
    q_m = jnp.concatenate([q_nope, q_pe], axis=-1)
    k_m = jnp.concatenate(
        [k_nope, jnp.broadcast_to(k_pe[:, :, None, :], (B, L, MLA_HEADS, MLA_ROPE))], axis=-1)
    o_mla = causal_block_attention(q_m, k_m, v_m, valid, (MLA_NOPE + MLA_ROPE) ** -0.5)
    o_mla = head_rms_norm(o_mla, out_norm_mla, MLA_HEADS)

    vf = valid.astype(jnp.float32)[None, :, None, None]
    gq = g_q.astype(jnp.float32).reshape(B, L, GLA_HEADS, GLA_DK) * (GLA_DK ** -0.5)
    gk = g_k.astype(jnp.float32).reshape(B, L, GLA_HEADS, GLA_DK) * vf
    gv = g_v.astype(jnp.float32).reshape(B, L, GLA_HEADS, GLA_DV)
    gate_logit = (g_z @ gla_w_gate2 + gla_b_gate).astype(jnp.float32)
    log_a = (jax.nn.log_sigmoid(gate_logit) / GLA_TAU).reshape(B, L, GLA_HEADS, GLA_DK) * vf
    o_gla = gla_chunked(gq, gk, gv, log_a).astype(hn.dtype)
    o_gla = head_rms_norm(o_gla, out_norm_gla, GLA_HEADS) * jax.nn.silu(g_r)

    fq = f_q.reshape(B, L, FOX_HEADS, FOX_DH)
    fk = f_k.reshape(B, L, FOX_HEADS, FOX_DH)
    fv = f_v.reshape(B, L, FOX_HEADS, FOX_DH)
    log_f = jax.nn.log_sigmoid((f_z + fox_b_f).astype(jnp.float32)) \
        * valid.astype(jnp.float32)[None, :, None]
    c = jnp.cumsum(log_f, axis=1)
    o_fox = causal_block_attention(fq, fk, fv, valid, FOX_DH ** -0.5, log_f_cum=c)
    o_fox = head_rms_norm(o_fox, out_norm_fox, FOX_HEADS)

    return jnp.concatenate([o_mla, o_gla, o_fox], axis=-1) @ w_out


def conv_ffn(hn, valid, w_up, conv_w, conv_b, w_down):
    L = hn.shape[1]
    u = (hn @ w_up) * valid.astype(hn.dtype)[None, :, None]
    u_pad = jnp.pad(u, ((0, 0), (CONV_W - 1, 0), (0, 0)))
    cv = conv_b + sum(conv_w[j] * u_pad[:, j:j + L] for j in range(CONV_W))
    gate, val = cv[..., :D_FF], cv[..., D_FF:]
    return (jax.nn.silu(gate) * val) @ w_down


def setup_inputs(seed: int = 0) -> dict:
    key = jax.random.key(seed)
    ks = jax.random.split(key, 24)
    f32 = jnp.float32
    nrm = lambda k, shape, s: jax.random.normal(k, shape, f32) * s
    gain = lambda k, shape: 1.0 + 0.02 * jax.random.normal(k, shape, f32)
    return {
        "x": nrm(ks[0], (BATCH, SEQ, D_MODEL), 1.0),
        "meta_tokens": nrm(ks[1], (N_META, D_MODEL), 1.0),
        "attn_norm": gain(ks[2], (DEPTH, D_MODEL)),
        "w_in": nrm(ks[3], (DEPTH, D_MODEL, D_IN), D_MODEL ** -0.5),
        "mla_q_norm": gain(ks[4], (DEPTH, MLA_Q_LORA)),
        "mla_w_uq": nrm(ks[5], (DEPTH, MLA_Q_LORA, MLA_HEADS * (MLA_NOPE + MLA_ROPE)), MLA_Q_LORA ** -0.5),
        "mla_kv_norm": gain(ks[6], (DEPTH, MLA_KV_LORA)),
        "mla_w_ukv": nrm(ks[7], (DEPTH, MLA_KV_LORA, MLA_HEADS * (MLA_NOPE + MLA_V)), MLA_KV_LORA ** -0.5),
        "gla_w_gate2": nrm(ks[8], (DEPTH, GLA_GATE_RANK, GLA_HEADS * GLA_DK), GLA_GATE_RANK ** -0.5),
        "gla_b_gate": nrm(ks[9], (DEPTH, GLA_HEADS * GLA_DK), 0.1),
        "fox_b_f": nrm(ks[10], (DEPTH, FOX_HEADS), 0.1),
        "out_norm_mla": gain(ks[11], (DEPTH, W_MLA)),
        "out_norm_gla": gain(ks[12], (DEPTH, W_GLA)),
        "out_norm_fox": gain(ks[13], (DEPTH, W_FOX)),
        "w_out": nrm(ks[14], (DEPTH, D_MIX, D_MODEL), D_MIX ** -0.5),
        "ffn_norm": gain(ks[15], (DEPTH, D_MODEL)),
        "ffn_w_up": nrm(ks[16], (DEPTH, D_MODEL, 2 * D_FF), D_MODEL ** -0.5),
        "ffn_conv_w": nrm(ks[17], (DEPTH, CONV_W, 2 * D_FF), CONV_W ** -0.5),
        "ffn_conv_b": nrm(ks[18], (DEPTH, 2 * D_FF), 0.02),
        "ffn_w_down": nrm(ks[19], (DEPTH, D_FF, D_MODEL), D_FF ** -0.5),
        "final_norm": gain(ks[20], (D_MODEL,)),
    }


def reference(x, meta_tokens, attn_norm, w_in, mla_q_norm, mla_w_uq, mla_kv_norm, mla_w_ukv,
              gla_w_gate2, gla_b_gate, fox_b_f, out_norm_mla, out_norm_gla, out_norm_fox,
              w_out, ffn_norm, ffn_w_up, ffn_conv_w, ffn_conv_b, ffn_w_down, final_norm):
    B = x.shape[0]
    meta = jnp.broadcast_to(meta_tokens.astype(x.dtype)[None], (B, N_META, D_MODEL))
    h = jnp.concatenate([jnp.zeros((B, N_PAD, D_MODEL), x.dtype), meta, x], axis=1)
    L = h.shape[1]
    idx = jnp.arange(L)
    valid = idx >= N_PAD
    vmask = valid.astype(x.dtype)[None, :, None]
    pos = jnp.maximum(idx - N_PAD, 0).astype(jnp.float32)
    inv_freq = 1.0 / (ROPE_THETA ** (jnp.arange(0, MLA_ROPE, 2, dtype=jnp.float32) / MLA_ROPE))
    ang = pos[:, None] * inv_freq[None, :]
    cos, sin = jnp.cos(ang), jnp.sin(ang)

    for layer in range(DEPTH):
        hn = rms_norm(h, attn_norm[layer])
        h = h + hybrid_mixer(hn, valid, cos, sin, w_in[layer], mla_q_norm[layer], mla_w_uq[layer],
                             mla_kv_norm[layer], mla_w_ukv[layer], gla_w_gate2[layer],
                             gla_b_gate[layer], fox_b_f[layer], out_norm_mla[layer],
                             out_norm_gla[layer], out_norm_fox[layer], w_out[layer]) * vmask
        hn = rms_norm(h, ffn_norm[layer])
        h = h + conv_ffn(hn, valid, ffn_w_up[layer], ffn_conv_w[layer], ffn_conv_b[layer],
                         ffn_w_down[layer]) * vmask

    return rms_norm(h, final_norm)[:, LEAD:]
```

```cpp
#include <hip/hip_runtime.h>
#include <cstdio>
#include <cstdint>
namespace pg8 {
#define PG8_LAS __attribute__((address_space(3)))
typedef unsigned short bf16_t;
typedef short bf16x8 __attribute__((ext_vector_type(8)));
typedef float f32x4 __attribute__((ext_vector_type(4)));
typedef unsigned u32x4 __attribute__((ext_vector_type(4)));
constexpr int BM = 256, BK = 64, HALF = 128, HTB = HALF * BK * 2  , STAGE_BYTES = 8 * HTB, NXCD = 8, WGM = 8;

__host__ __device__ __forceinline__ int lds_byte(int r, int c) { const int st = (r >> 4) * 2 + (c >> 5), rr = r & 15, cc = c & 31, ob = rr * 64 + cc * 2; return st * 1024 + (ob ^ (((ob >> 9) & 1) << 5)); }
__host__ __device__ __forceinline__ void stage_rc(int b, int& R, int& C) { const int st = b / 1024, sb = b % 1024, swz = sb ^ (((sb >> 9) & 1) << 5); R = (st >> 1) * 16 + swz / 64; C = (st & 1) * 32 + (swz % 64) / 2; }
__host__ __device__ __forceinline__ int perm32(int rho) { const int n = rho >> 4, i = rho & 15; return 8 * (i >> 2) + 4 * n + (i & 3); }

struct Unit { int pm, pn; };
__host__ __device__ __forceinline__ int prow(int pm) { return (pm >> 4) * 4224 + 128 + (pm & 15) * 256; }
struct Gemm { const bf16_t* A; const bf16_t* Bt; int M, N, K; };

struct StaticOrder {
    int nM, nN, nwg, G, c;
    __host__ __device__ void init(int M, int N, int G_, int c_) { nM = M / BM; nN = N / BM; nwg = nM * nN; G = G_; c = c_; }
    __host__ __device__ bool next(int i, Unit& u) const {
        const long L = (long)i * G + c; if (L >= nwg) return false;
        int wgid = (int)L; { const int q = nwg / NXCD, r = nwg % NXCD, xcd = wgid % NXCD, off = wgid / NXCD; wgid = (xcd < r ? xcd * (q + 1) : r * (q + 1) + (xcd - r) * q) + off; }
        const int nig = WGM * nN, gid = wgid / nig, fm = gid * WGM, gsz = (nM - fm) < WGM ? (nM - fm) : WGM;
        u.pm = fm + ((wgid % nig) % gsz); u.pn = (wgid % nig) / gsz; return true;
    }
    __device__ __forceinline__ void a_ready(const Unit&) const {}
    __device__ __forceinline__ void done(const Unit&) const {}
};
typedef int i32x4 __attribute__((ext_vector_type(4)));
template <bool I8> struct AccSel { typedef f32x4 type; };
template <> struct AccSel<true> { typedef i32x4 type; };
__device__ __forceinline__ unsigned cvt_pk_bf16(float lo, float hi) { unsigned r; asm volatile("v_cvt_pk_bf16_f32 %0, %1, %2" : "=v"(r) : "v"(lo), "v"(hi)); return r; }
constexpr int EPI_LROWS = 4224, EPI_NPAD = 112;
struct EpiBf {
    static constexpr bool PERM = true, AFTER_DRAIN = false, APERM = false;
    bf16_t* O; int ldc; int nbf; int rope_from; float* F; int ldf; const float* cs; const unsigned long long* ssq;
    __device__ __forceinline__ void operator()(const f32x4 (&acc)[2][2][4][2], const Unit& u, int wr, int wc, int fr, int fq) const {
        const int row0 = prow(u.pm) + wr * 64 + fr, col0 = u.pn * BM + wc * 32 + 8 * fq;
        float rsc[2][4];
        if (ssq) { unsigned long long q[2][4];
#pragma unroll
            for (int ai = 0; ai < 2; ++ai)
#pragma unroll
                for (int m = 0; m < 4; ++m) q[ai][m] = ssq[row0 + ai * HALF + m * 16];
#pragma unroll
            for (int ai = 0; ai < 2; ++ai)
#pragma unroll
                for (int m = 0; m < 4; ++m) rsc[ai][m] = 1.0f / sqrtf((float)q[ai][m] * (1.0f / 4294967296.0f / 4096.0f) + 1e-6f);
        } else {
#pragma unroll
            for (int ai = 0; ai < 2; ++ai)
#pragma unroll
                for (int m = 0; m < 4; ++m) rsc[ai][m] = 1.0f;
        }
        if (u.pn < nbf) {
            const bool rope = u.pn >= rope_from;
#pragma unroll
            for (int ai = 0; ai < 2; ++ai)
#pragma unroll
                for (int m = 0; m < 4; ++m) { const int row = row0 + ai * HALF + m * 16; bf16_t* rowp = O + (size_t)row * ldc + col0;
#pragma unroll
                    for (int bj = 0; bj < 2; ++bj) { f32x4 v0 = acc[ai][bj][m][0] * rsc[ai][m], v1 = acc[ai][bj][m][1] * rsc[ai][m];
                        if (rope) { const int p = row % EPI_LROWS, i0 = ((col0 + bj * HALF) & 63) >> 1; const float* t = cs + ((size_t)p * 32 + i0) * 2;
                            const f32x4 t0 = *(const f32x4*)t, t1 = *(const f32x4*)(t + 4);
                            const f32x4 a = v0, b = v1;
                            v0[0] = a[0] * t0[0] - a[1] * t0[1]; v0[1] = a[1] * t0[0] + a[0] * t0[1]; v0[2] = a[2] * t0[2] - a[3] * t0[3]; v0[3] = a[3] * t0[2] + a[2] * t0[3];
                            v1[0] = b[0] * t1[0] - b[1] * t1[1]; v1[1] = b[1] * t1[0] + b[0] * t1[1]; v1[2] = b[2] * t1[2] - b[3] * t1[3]; v1[3] = b[3] * t1[2] + b[2] * t1[3]; }
                        u32x4 w; w.x = cvt_pk_bf16(v0[0], v0[1]); w.y = cvt_pk_bf16(v0[2], v0[3]); w.z = cvt_pk_bf16(v1[0], v1[1]); w.w = cvt_pk_bf16(v1[2], v1[3]);
                        __builtin_nontemporal_store(w, (u32x4*)(rowp + bj * HALF)); } }
        } else {
            const int fc0 = col0 - nbf * BM;
#pragma unroll
            for (int ai = 0; ai < 2; ++ai)
#pragma unroll
                for (int m = 0; m < 4; ++m) { const int row = row0 + ai * HALF + m * 16; float* rowp = F + (size_t)row * ldf + fc0;
#pragma unroll
                    for (int bj = 0; bj < 2; ++bj) { *(f32x4*)(rowp + bj * HALF) = acc[ai][bj][m][0] * rsc[ai][m]; *(f32x4*)(rowp + bj * HALF + 4) = acc[ai][bj][m][1] * rsc[ai][m]; } }
        }
    }
};
template <bool SSQ> struct EpiRes {
    static constexpr bool PERM = true, AFTER_DRAIN = false, APERM = false;
    bf16_t* H; int ldc; unsigned long long* ssq;
    __device__ __forceinline__ void operator()(const f32x4 (&acc)[2][2][4][2], const Unit& u, int wr, int wc, int fr, int fq) const {
        char* hb = (char*)(H + (size_t)prow(u.pm) * ldc + u.pn * BM);
        const unsigned lo = (unsigned)((wr * 64 + fr) * ldc + wc * 32 + 8 * fq) * 2u;
        u32x4 r[2][4][2];
#pragma unroll
        for (int ai = 0; ai < 2; ++ai)
#pragma unroll
            for (int m = 0; m < 4; ++m)
#pragma unroll
                for (int bj = 0; bj < 2; ++bj) r[ai][m][bj] = *(const u32x4*)(hb + lo + (unsigned)((ai * HALF + m * 16) * ldc + bj * HALF) * 2u);
#pragma unroll
        for (int ai = 0; ai < 2; ++ai)
#pragma unroll
            for (int m = 0; m < 4; ++m)
#pragma unroll
                for (int bj = 0; bj < 2; ++bj) { const u32x4 q = r[ai][m][bj]; const f32x4 v0 = acc[ai][bj][m][0], v1 = acc[ai][bj][m][1]; u32x4 w;
                    w.x = cvt_pk_bf16(v0[0] + __uint_as_float(q.x << 16), v0[1] + __uint_as_float(q.x & 0xffff0000u));
                    w.y = cvt_pk_bf16(v0[2] + __uint_as_float(q.y << 16), v0[3] + __uint_as_float(q.y & 0xffff0000u));
                    w.z = cvt_pk_bf16(v1[0] + __uint_as_float(q.z << 16), v1[1] + __uint_as_float(q.z & 0xffff0000u));
                    w.w = cvt_pk_bf16(v1[2] + __uint_as_float(q.w << 16), v1[3] + __uint_as_float(q.w & 0xffff0000u));
                    __builtin_nontemporal_store(w, (u32x4*)(hb + lo + (unsigned)((ai * HALF + m * 16) * ldc + bj * HALF) * 2u));
                    if constexpr (SSQ) { r[ai][m][bj] = w; } }
        if constexpr (SSQ) {
            const int rowb = prow(u.pm) + wr * 64 + fr;
#pragma unroll
            for (int ai = 0; ai < 2; ++ai)
#pragma unroll
                for (int m = 0; m < 4; ++m) { float s = 0.f;
#pragma unroll
                    for (int bj = 0; bj < 2; ++bj) { const u32x4 w = r[ai][m][bj];
#pragma unroll
                        for (int e = 0; e < 4; ++e) { const float x0 = __uint_as_float(w[e] << 16), x1 = __uint_as_float(w[e] & 0xffff0000u); s += x0 * x0 + x1 * x1; } }
                    s += __shfl_xor(s, 16); s += __shfl_xor(s, 32);
                    if (fq == 0) atomicAdd(ssq + rowb + ai * HALF + m * 16, (unsigned long long)(s * 4294967296.0f)); }
        }
    }
};
template <bool I8> struct EpiConv {
    static constexpr bool PERM = true, AFTER_DRAIN = false, APERM = true;
    bf16_t* ACT; float* EDGE; const float* cw; const float* cb; PG8_LAS float* EX; const float* asc; const float* wsc;
    static __device__ __forceinline__ float shr1(float oldv, float src) { return __int_as_float(__builtin_amdgcn_update_dpp(__float_as_int(oldv), __float_as_int(src), 0x111, 0xf, 0xf, false)); }
    __device__ __forceinline__ void operator()(typename AccSel<I8>::type (&acc)[2][2][4][2], const Unit& u, int wr, int wc, int fr_in, int fq_in) const {
        constexpr int NUPc = 22016, DFFc = 11008;
        (void)fr_in; (void)fq_in; int ln_; asm volatile("v_mbcnt_lo_u32_b32 %0, -1, 0\n\tv_mbcnt_hi_u32_b32 %0, -1, %0" : "=v"(ln_));
        int fr = ln_ & 15, fq = ln_ >> 4;
        const int chb = wc * 32 + 8 * fq, prow0 = prow(u.pm);
#define EC_F(ai_, bj_, m_, n_) __builtin_bit_cast(f32x4, acc[ai_][bj_][m_][n_])
        PG8_LAS float* CWL = EX + 2048;
        PG8_LAS float* WSL = EX + 2048 + 1024;
        PG8_LAS float* ASL = EX + 2048 + 1024 + 256;
        {
            const int t_ = (wr * 4 + wc) * 64 + ln_;
            if (t_ < 256) { const int v = t_ >> 5, c4 = (t_ & 31) * 4, vv = v & 3; const float* sp = (vv < 3 ? cw + vv * NUPc : cb) + (v >> 2) * DFFc + u.pn * 128 + c4;
                *(PG8_LAS f32x4*)(CWL + v * 128 + c4) = *(const f32x4*)sp; }
            else if (I8 && t_ < 320) { const int j = t_ - 256; *(PG8_LAS f32x4*)(WSL + 4 * j) = *(const f32x4*)(wsc + u.pn * 256 + 4 * j); }
            else if (I8 && t_ < 384) { const int j = t_ - 320; *(PG8_LAS f32x4*)(ASL + 4 * j) = *(const f32x4*)(asc + prow0 + 4 * j); }
        }
        asm volatile("s_waitcnt vmcnt(0) lgkmcnt(0)" ::: "memory"); __builtin_amdgcn_s_barrier(); asm volatile("" ::: "memory");
        if constexpr (I8) {
            f32x4 as_[2];
#pragma unroll
            for (int ai = 0; ai < 2; ++ai) as_[ai] = *(const PG8_LAS f32x4*)(ASL + 128 * ai + 64 * wr + 4 * fr);
#pragma unroll
            for (int bj = 0; bj < 2; ++bj)
#pragma unroll
                for (int n = 0; n < 2; ++n) { const f32x4 wsv = *(const PG8_LAS f32x4*)(WSL + bj * 128 + chb + 4 * n);
#pragma unroll
                    for (int ai = 0; ai < 2; ++ai)
#pragma unroll
                        for (int m = 0; m < 4; ++m) { const i32x4 q = __builtin_bit_cast(i32x4, acc[ai][bj][m][n]); f32x4 f; f[0] = (float)q[0]; f[1] = (float)q[1]; f[2] = (float)q[2]; f[3] = (float)q[3];
                            f = f * wsv * as_[ai][m]; acc[ai][bj][m][n] = __builtin_bit_cast(typename AccSel<I8>::type, f); } }
        }
        if (fr == 15) {
#pragma unroll
            for (int ai = 0; ai < 2; ++ai)
#pragma unroll
                for (int mm = 2; mm < 4; ++mm)
#pragma unroll
                    for (int bj = 0; bj < 2; ++bj)
#pragma unroll
                        for (int n = 0; n < 2; ++n) *(PG8_LAS f32x4*)(EX + (((2 * ai + wr) * 2 + (mm - 2)) * 256 + bj * 128 + chb + 4 * n)) = EC_F(ai, bj, mm, n);
        }
        char* eg = (char*)(EDGE + (size_t)u.pm * 4 * NUPc + u.pn * 256);
        if (wr == 0 && fr == 0) {
#pragma unroll
            for (int mm = 0; mm < 2; ++mm)
#pragma unroll
                for (int bj = 0; bj < 2; ++bj)
#pragma unroll
                    for (int n = 0; n < 2; ++n) *(f32x4*)(eg + (unsigned)(mm * NUPc + chb) * 4u + (bj * 128 + 4 * n) * 4) = EC_F(0, bj, mm, n);
        }
        if (wr == 1 && fr == 15) {
#pragma unroll
            for (int mm = 2; mm < 4; ++mm)
#pragma unroll
                for (int bj = 0; bj < 2; ++bj)
#pragma unroll
                    for (int n = 0; n < 2; ++n) *(f32x4*)(eg + (unsigned)(mm * NUPc + chb) * 4u + (bj * 128 + 4 * n) * 4) = EC_F(1, bj, mm, n);
        }
        asm volatile("s_waitcnt lgkmcnt(0)" ::: "memory"); __builtin_amdgcn_s_barrier(); asm volatile("" ::: "memory");
        unsigned pk0[2][4][2];
#pragma unroll
        for (int n = 0; n < 2; ++n) {
            asm volatile("" : "+v"(fr));
            const int ch = u.pn * 128 + chb + 4 * n;
            const PG8_LAS float* cwl = CWL + chb + 4 * n;
            const f32x4 wg0 = *(const PG8_LAS f32x4*)cwl, wg1 = *(const PG8_LAS f32x4*)(cwl + 128), wg2 = *(const PG8_LAS f32x4*)(cwl + 256), bg = *(const PG8_LAS f32x4*)(cwl + 384);
            const f32x4 wv0 = *(const PG8_LAS f32x4*)(cwl + 512), wv1 = *(const PG8_LAS f32x4*)(cwl + 640), wv2 = *(const PG8_LAS f32x4*)(cwl + 768), bv = *(const PG8_LAS f32x4*)(cwl + 896);
#pragma unroll
            for (int ai = 0; ai < 2; ++ai) {
                const int q = 2 * ai + wr;
                f32x4 hg1 = {0.f, 0.f, 0.f, 0.f}, hg2 = hg1, hv1 = hg1, hv2 = hg1;
                if (q >= 1) { const PG8_LAS float* hx = EX + ((q - 1) * 2) * 256 + chb + 4 * n;
                    hg2 = *(const PG8_LAS f32x4*)hx; hg1 = *(const PG8_LAS f32x4*)(hx + 256); hv2 = *(const PG8_LAS f32x4*)(hx + 128); hv1 = *(const PG8_LAS f32x4*)(hx + 256 + 128); }
                float o[4][4];
#pragma unroll
                for (int e = 0; e < 4; ++e) {
                    const float g0 = EC_F(ai, 0, 0, n)[e], g1 = EC_F(ai, 0, 1, n)[e], g2 = EC_F(ai, 0, 2, n)[e], g3 = EC_F(ai, 0, 3, n)[e];
                    const float v0 = EC_F(ai, 1, 0, n)[e], v1 = EC_F(ai, 1, 1, n)[e], v2 = EC_F(ai, 1, 2, n)[e], v3 = EC_F(ai, 1, 3, n)[e];
                    const float gm1 = shr1(hg1[e], g3), gm2 = shr1(hg2[e], g2), vm1 = shr1(hv1[e], v3), vm2 = shr1(hv2[e], v2);
                    const float cg0 = bg[e] + wg0[e] * gm2 + wg1[e] * gm1 + wg2[e] * g0, cv0 = bv[e] + wv0[e] * vm2 + wv1[e] * vm1 + wv2[e] * v0;
                    const float cg1 = bg[e] + wg0[e] * gm1 + wg1[e] * g0 + wg2[e] * g1, cv1 = bv[e] + wv0[e] * vm1 + wv1[e] * v0 + wv2[e] * v1;
                    const float cg2 = bg[e] + wg0[e] * g0 + wg1[e] * g1 + wg2[e] * g2, cv2 = bv[e] + wv0[e] * v0 + wv1[e] * v1 + wv2[e] * v2;
                    const float cg3 = bg[e] + wg0[e] * g1 + wg1[e] * g2 + wg2[e] * g3, cv3 = bv[e] + wv0[e] * v1 + wv1[e] * v2 + wv2[e] * v3;
                    o[0][e] = cg0 * __builtin_amdgcn_rcpf(1.0f + __expf(-cg0)) * cv0; o[1][e] = cg1 * __builtin_amdgcn_rcpf(1.0f + __expf(-cg1)) * cv1;
                    o[2][e] = cg2 * __builtin_amdgcn_rcpf(1.0f + __expf(-cg2)) * cv2; o[3][e] = cg3 * __builtin_amdgcn_rcpf(1.0f + __expf(-cg3)) * cv3;
                }
#pragma unroll
                for (int m = 0; m < 4; ++m) {
                    if (n == 0) { pk0[ai][m][0] = cvt_pk_bf16(o[m][0], o[m][1]); pk0[ai][m][1] = cvt_pk_bf16(o[m][2], o[m][3]); }
                    else if (!(q == 0 && fr == 0 && m < 2)) {
                        u32x4 w; w.x = pk0[ai][m][0]; w.y = pk0[ai][m][1]; w.z = cvt_pk_bf16(o[m][0], o[m][1]); w.w = cvt_pk_bf16(o[m][2], o[m][3]);
                        __builtin_nontemporal_store(w, (u32x4*)(ACT + (size_t)(prow0 + 128 * ai + 64 * wr + 4 * fr + m) * DFFc + (ch - 4)));
                    }
                }
            }
        }
    }
#undef EC_F
};
template <class Epi, class Sched, bool ALIGN_EPI = false, bool SP2 = false, bool I8 = false>
__device__ __forceinline__ void gemm_phase(PG8_LAS unsigned char* lds, const Gemm g, const Sched& S, const Epi& E, const int wave_s) {
    int lane_; asm volatile("v_mbcnt_lo_u32_b32 %0, -1, 0\n\tv_mbcnt_hi_u32_b32 %0, -1, %0" : "=v"(lane_));
    const int wid = wave_s, lane = lane_, tid = wid * 64 + lane, wr = wid >> 2, wc = wid & 3, fr = lane & 15, fq = lane >> 4;
    const int K = g.K, nt = K / BK;
    unsigned voffA[2], voffB[2];
#pragma unroll
    for (int i = 0; i < 2; ++i) { int R, C; stage_rc(tid * 16 + i * 8192, R, C); const int Rb = Epi::PERM ? ((R & ~31) + perm32(R & 31)) : R;
        const int Ra = Epi::APERM ? ((R & ~63) + 4 * (R & 15) + ((R >> 4) & 3)) : R;
        voffA[i] = (unsigned)(Ra * K + C) * 2u; voffB[i] = (unsigned)(Rb * K + C) * 2u; }
    const size_t kstep = (size_t)(BK * 2);
    const size_t hstep = (size_t)HALF * K * 2;
    const size_t tstep = 2 * hstep;
    const unsigned ldsw = (unsigned)wid * 1024u;
    const int aoff = lds_byte(wr * 64 + fr, fq * 8), boff = lds_byte(wc * 32 + fr, fq * 8);
#define PG8_SA(b, h) (((b) * 2 + (h)) * HTB)
#define PG8_SB(b, h) ((4 + (b) * 2 + (h)) * HTB)
#define PG8_STAGE(bufoff, gbase, voff) do { _Pragma("unroll") for (int _i = 0; _i < 2; ++_i) \
        __builtin_amdgcn_global_load_lds((const unsigned*)((const char*)(gbase) + (voff)[_i]), (PG8_LAS unsigned*)(lds + (bufoff) + ldsw + _i * 8192), 16, 0, 0); } while (0)
#define PG8_LDA(dst, b, h) do { _Pragma("unroll") for (int m = 0; m < 4; ++m) _Pragma("unroll") for (int k = 0; k < 2; ++k) dst[m][k] = *(const PG8_LAS bf16x8*)(lds + PG8_SA(b, h) + aoff + m * 2048 + k * 1024); } while (0)
#define PG8_LDB(dst, b, h) do { _Pragma("unroll") for (int n = 0; n < 2; ++n) _Pragma("unroll") for (int k = 0; k < 2; ++k) dst[n][k] = *(const PG8_LAS bf16x8*)(lds + PG8_SB(b, h) + boff + n * 2048 + k * 1024); } while (0)
#define PG8_MMA(ai, bj, At, Bt) do { __builtin_amdgcn_s_setprio(1); _Pragma("unroll") for (int m = 0; m < 4; ++m) _Pragma("unroll") for (int n = 0; n < 2; ++n) _Pragma("unroll") for (int k = 0; k < 2; ++k) { \
        if constexpr (I8) acc[ai][bj][m][n] = __builtin_bit_cast(acc_t, __builtin_amdgcn_mfma_i32_16x16x64_i8(__builtin_bit_cast(i32x4, Bt[n][k]), __builtin_bit_cast(i32x4, At[m][k]), __builtin_bit_cast(i32x4, acc[ai][bj][m][n]), 0, 0, 0)); \
        else acc[ai][bj][m][n] = __builtin_bit_cast(acc_t, __builtin_amdgcn_mfma_f32_16x16x32_bf16(Bt[n][k], At[m][k], __builtin_bit_cast(f32x4, acc[ai][bj][m][n]), 0, 0, 0)); } \
        __builtin_amdgcn_s_setprio(0); } while (0)
#define PG8_WAIT_V(n) asm volatile("s_waitcnt vmcnt(" #n ")" ::: "memory")
#define PG8_WAIT_L(n) asm volatile("s_waitcnt lgkmcnt(" #n ")" ::: "memory")
#define PG8_BAR __builtin_amdgcn_s_barrier()
#define PG8_SCHED __builtin_amdgcn_sched_barrier(0)
    Unit cur, nxt; int ui = 0;
    if (!S.next(0, cur)) return;
    typedef typename AccSel<I8>::type acc_t;
    acc_t acc[2][2][4][2];
#pragma unroll
    for (int a = 0; a < 2; ++a)
#pragma unroll
        for (int b = 0; b < 2; ++b)
#pragma unroll
            for (int m = 0; m < 4; ++m)
#pragma unroll
                for (int n = 0; n < 2; ++n) acc[a][b][m][n] = __builtin_bit_cast(acc_t, (f32x4){0.f, 0.f, 0.f, 0.f});
    bf16x8 At[4][2], B0[2][2], B1[2][2];
    const char* cA = (const char*)g.A + (size_t)prow(cur.pm) * K * 2; const char* cB = (const char*)g.Bt + (size_t)cur.pn * tstep;
    S.a_ready(cur);
    if constexpr (SP2) {
        PG8_STAGE(PG8_SB(0, 0), cB, voffB); PG8_STAGE(PG8_SB(0, 1), cB + hstep, voffB); PG8_STAGE(PG8_SA(0, 0), cA, voffA); PG8_STAGE(PG8_SA(0, 1), cA + hstep, voffA);
        if (wr == 1) PG8_BAR;
        PG8_WAIT_V(2); PG8_BAR;
        PG8_STAGE(PG8_SB(1, 0), cB + kstep, voffB); PG8_STAGE(PG8_SA(1, 0), cA + kstep, voffA); PG8_STAGE(PG8_SB(1, 1), cB + hstep + kstep, voffB);
        PG8_WAIT_V(6); PG8_BAR;
    } else {
        PG8_STAGE(PG8_SB(0, 0), cB, voffB); PG8_STAGE(PG8_SA(0, 0), cA, voffA); PG8_STAGE(PG8_SB(0, 1), cB + hstep, voffB); PG8_STAGE(PG8_SA(0, 1), cA + hstep, voffA);
        if (wr == 1) PG8_BAR;
        PG8_WAIT_V(4); PG8_BAR;
        PG8_STAGE(PG8_SB(1, 0), cB + kstep, voffB); PG8_STAGE(PG8_SA(1, 0), cA + kstep, voffA); PG8_STAGE(PG8_SB(1, 1), cB + hstep + kstep, voffB);
        PG8_WAIT_V(6); PG8_BAR;
    }
    for (;;) {
        const bool has_next = S.next(ui + 1, nxt);
        const char* nA = has_next ? (const char*)g.A + (size_t)prow(nxt.pm) * K * 2 : cA; const char* nB = has_next ? (const char*)g.Bt + (size_t)nxt.pn * tstep : cB;
        for (int t = 0; t < nt; t += 2) {
            const bool last = (t == nt - 2);
            const char* a1 = cA + (size_t)(t + 1) * kstep;
            const char* a2 = last ? nA : cA + (size_t)(t + 2) * kstep; const char* b2 = last ? nB : cB + (size_t)(t + 2) * kstep;
            const char* a3 = a2 + kstep; const char* b3 = b2 + kstep;
            if (last && has_next) S.a_ready(nxt);
            if constexpr (SP2) {
            PG8_LDB(B0, 0, 0); PG8_LDB(B1, 0, 1); PG8_SCHED; PG8_LDA(At, 0, 0); PG8_STAGE(PG8_SA(1, 1), a1 + hstep, voffA);
            PG8_WAIT_V(8); PG8_WAIT_L(0); PG8_BAR; PG8_MMA(0, 0, At, B0); PG8_MMA(0, 1, At, B1); PG8_BAR; PG8_SCHED;
            PG8_LDA(At, 0, 1); PG8_STAGE(PG8_SB(0, 0), b2, voffB); PG8_STAGE(PG8_SB(0, 1), b2 + hstep, voffB); PG8_STAGE(PG8_SA(0, 0), a2, voffA);
            PG8_WAIT_V(8); PG8_WAIT_L(0); PG8_BAR; PG8_MMA(1, 0, At, B0); PG8_MMA(1, 1, At, B1); PG8_BAR; PG8_SCHED;
            PG8_LDB(B0, 1, 0); PG8_LDB(B1, 1, 1); PG8_SCHED; PG8_LDA(At, 1, 0); PG8_STAGE(PG8_SA(0, 1), a2 + hstep, voffA);
            PG8_WAIT_V(8); PG8_WAIT_L(0); PG8_BAR; PG8_MMA(0, 0, At, B0); PG8_MMA(0, 1, At, B1); PG8_BAR; PG8_SCHED;
            PG8_LDA(At, 1, 1); PG8_STAGE(PG8_SB(1, 0), b3, voffB); PG8_STAGE(PG8_SB(1, 1), b3 + hstep, voffB); PG8_STAGE(PG8_SA(1, 0), a3, voffA);
            PG8_WAIT_V(8); PG8_WAIT_L(0); PG8_BAR; PG8_MMA(1, 0, At, B0); PG8_MMA(1, 1, At, B1); PG8_BAR; PG8_SCHED;
            } else {
            PG8_LDB(B0, 0, 0); PG8_SCHED; PG8_LDA(At, 0, 0); PG8_STAGE(PG8_SA(1, 1), a1 + hstep, voffA);
            PG8_WAIT_L(8); PG8_BAR; PG8_WAIT_L(0); PG8_MMA(0, 0, At, B0); PG8_BAR; PG8_SCHED;
            PG8_LDB(B1, 0, 1); PG8_STAGE(PG8_SB(0, 0), b2, voffB);
            PG8_BAR; PG8_WAIT_L(0); PG8_MMA(0, 1, At, B1); PG8_BAR;
            PG8_LDA(At, 0, 1); PG8_STAGE(PG8_SA(0, 0), a2, voffA);
            PG8_BAR; PG8_WAIT_L(0); PG8_MMA(1, 0, At, B0); PG8_BAR; PG8_SCHED;
            PG8_STAGE(PG8_SB(0, 1), b2 + hstep, voffB);
            PG8_WAIT_V(6); PG8_BAR; PG8_MMA(1, 1, At, B1); PG8_BAR;
            PG8_LDB(B0, 1, 0); PG8_SCHED; PG8_LDA(At, 1, 0); PG8_STAGE(PG8_SA(0, 1), a2 + hstep, voffA);
            PG8_WAIT_L(8); PG8_BAR; PG8_WAIT_L(0); PG8_MMA(0, 0, At, B0); PG8_BAR; PG8_SCHED;
            PG8_LDB(B1, 1, 1); PG8_STAGE(PG8_SB(1, 0), b3, voffB);
            PG8_BAR; PG8_WAIT_L(0); PG8_MMA(0, 1, At, B1); PG8_BAR;
            PG8_LDA(At, 1, 1); PG8_STAGE(PG8_SA(1, 0), a3, voffA);
            PG8_BAR; PG8_WAIT_L(0); PG8_MMA(1, 0, At, B0); PG8_BAR; PG8_SCHED;
            PG8_STAGE(PG8_SB(1, 1), b3 + hstep, voffB);
            PG8_WAIT_V(6); PG8_BAR; PG8_MMA(1, 1, At, B1); PG8_BAR;
            }
        }
        if constexpr (ALIGN_EPI) { if (wr == 0) PG8_BAR; }
        if constexpr (!Epi::AFTER_DRAIN) { E(acc, cur, wr, wc, fr, fq); S.done(cur); }
        if (!has_next) break;
#pragma unroll
        for (int a = 0; a < 2; ++a)
#pragma unroll
            for (int b = 0; b < 2; ++b)
#pragma unroll
                for (int m = 0; m < 4; ++m)
#pragma unroll
                    for (int n = 0; n < 2; ++n) acc[a][b][m][n] = __builtin_bit_cast(acc_t, (f32x4){0.f, 0.f, 0.f, 0.f});
        cur = nxt; cA = nA; cB = nB; ++ui;
        if constexpr (ALIGN_EPI) { if (wr == 1) PG8_BAR; }
    }
    PG8_WAIT_V(0);
    if constexpr (!ALIGN_EPI) { if (wr == 0) PG8_BAR; }
    PG8_BAR;
    if constexpr (Epi::AFTER_DRAIN) { E.fused(acc, cur, wr, wc, fr, fq, lds, wid, lane); S.done(cur); }
#undef PG8_SA
#undef PG8_SB
#undef PG8_STAGE
#undef PG8_LDA
#undef PG8_LDB
#undef PG8_MMA
#undef PG8_WAIT_V
#undef PG8_WAIT_L
#undef PG8_BAR
#undef PG8_SCHED
}
}

#define LAS __attribute__((address_space(3)))
#define XB_TMO      128
#define XB_XCNT(j)  (256  + 64 * (j))
#define XB_XSUB(j)  (1280 + 64 * (j))
#define XB_XGEN(j)  (2304 + 64 * (j))
#define XB_TOP      3328
#define XB_TOPGEN   3392
#define XCD_BAR_WORDS 3456
#define XB_SPIN_CAP (1u << 18)

__device__ __forceinline__ unsigned xb_ld(unsigned* p)              { return __hip_atomic_load(p, __ATOMIC_RELAXED, __HIP_MEMORY_SCOPE_AGENT); }
__device__ __forceinline__ unsigned xb_add(unsigned* p, unsigned v) { return __hip_atomic_fetch_add(p, v, __ATOMIC_RELAXED, __HIP_MEMORY_SCOPE_AGENT); }
__device__ __forceinline__ unsigned xb_xcc_id() { return (unsigned)__builtin_amdgcn_s_getreg((3 << 11) | 20) & 0xFu; }
#define XB_SPIN(cond, bar) do { unsigned _sp = 0; while (cond) { __builtin_amdgcn_s_sleep(1); \
    if ((++_sp & 255u) == 0u) { if (xb_ld(&(bar)[XB_TMO])) break; if (_sp > XB_SPIN_CAP) { atomicAdd(&(bar)[XB_TMO], 1u); break; } } } } while (0)

struct XcdBarrier {
    unsigned* bar; unsigned x; unsigned w0;
    volatile LAS unsigned* st;
};

__device__ __forceinline__ XcdBarrier xcd_barrier_post(unsigned* bar, volatile LAS unsigned* st) {
    XcdBarrier b; b.bar = bar; b.x = xb_xcc_id(); b.st = st; b.w0 = threadIdx.x < 64 ? 1u : 0u;
    if (threadIdx.x == 0) (void)xb_add(&bar[XB_XCNT(b.x)], 1u);
    return b;
}
__device__ __forceinline__ void xcd_barrier_complete(unsigned* bar, unsigned x, unsigned& nloc, unsigned& nx) {
    const unsigned G = gridDim.x * gridDim.y * gridDim.z;
    unsigned sum, cnt, mine, sp = 0u;
    for (;;) {
        sum = 0u; cnt = 0u; mine = 0u;
#pragma unroll
        for (unsigned j = 0; j < 16; ++j) { const unsigned c = xb_ld(&bar[XB_XCNT(j)]); sum += c; cnt += (c > 0u) ? 1u : 0u; mine = (j == x) ? c : mine; }
        if (sum == G) break;
        __builtin_amdgcn_s_sleep(1);
        if ((++sp & 255u) == 0u) { if (xb_ld(&bar[XB_TMO])) break; if (sp > XB_SPIN_CAP) { atomicAdd(&bar[XB_TMO], 1u); break; } }
    }
    nloc = mine > 0u ? mine : 1u; nx = cnt > 0u ? cnt : 1u;
}

__device__ __forceinline__ void xcd_barrier(const XcdBarrier& b) {
    asm volatile("s_waitcnt vmcnt(0)" ::: "memory");
    __syncthreads();
    int xb_lane; asm volatile("v_mbcnt_lo_u32_b32 %0, -1, 0\n\tv_mbcnt_hi_u32_b32 %0, -1, %0" : "=v"(xb_lane));
    if (b.w0 != 0u && xb_lane == 0) {
        unsigned* bar = b.bar;
        __builtin_amdgcn_s_waitcnt(0);
        unsigned nloc = b.st[0], nx = b.st[1];
        if (nloc == 0u) { xcd_barrier_complete(bar, b.x, nloc, nx); b.st[0] = nloc; b.st[1] = nx; }
        const unsigned old = xb_add(&bar[XB_XSUB(b.x)], 1u);
        const unsigned gen = old / nloc;
        if (old + 1u == (gen + 1u) * nloc) {
            __builtin_amdgcn_fence(__ATOMIC_RELEASE, "agent");
            asm volatile("s_waitcnt vmcnt(0)" ::: "memory");
            const unsigned og = xb_add(&bar[XB_TOP], 1u);
            const unsigned tg = og / nx;
            if (og + 1u == (tg + 1u) * nx) xb_add(&bar[XB_TOPGEN], 1u);
            else XB_SPIN(xb_ld(&bar[XB_TOPGEN]) == tg, bar);
            __builtin_amdgcn_fence(__ATOMIC_ACQUIRE, "agent");
            xb_add(&bar[XB_XGEN(b.x)], 1u);
            asm volatile("s_waitcnt vmcnt(0)" ::: "memory");
        } else {
            XB_SPIN(xb_ld(&bar[XB_XGEN(b.x)]) == gen, bar);
            __builtin_amdgcn_fence(__ATOMIC_ACQUIRE, "agent");
            asm volatile("s_waitcnt vmcnt(0)" ::: "memory");
        }
    }
    __syncthreads();
}

typedef pg8::bf16_t bf16_t; typedef pg8::bf16x8 bf16x8; typedef pg8::f32x4 f32x4; typedef pg8::u32x4 u32x4;
typedef unsigned u32x2 __attribute__((ext_vector_type(2)));
constexpr int NB = 2, SEQ = 4096, LEAD = 128, LL = 4224, NPAD = 112, R = NB * LL, DM = 4096;
constexpr int NPROJ = 9728, NIN = 9984, NSM = 256, DFF = 11008, NUP = 22016, NQ = 2304, NKV = 3072;
constexpr int GCH = 66, GUNITS = NB * 4 * GCH;
constexpr float EPS = 1e-6f;
constexpr int PC_FQ = 2048, PC_FK = 3584, PC_FV = 5120, PC_GQ = 6656, PC_GK = 7168, PC_GV = 7680, PC_GR = 8704;

constexpr size_t MiB = 1u << 20;
constexpr size_t al(size_t x) { return (x + MiB - 1) / MiB * MiB; }
constexpr size_t WS_CTL = 0, CTL_ZERO_BYTES = MiB;
constexpr size_t WS_CS = 1 * MiB;
constexpr size_t WS_W = 4 * MiB;
constexpr size_t SZ_WIN = (size_t)NIN * DM * 2, SZ_WUQ = (size_t)NQ * 1536 * 2, SZ_WUKV = (size_t)NKV * 512 * 2, SZ_WOUT = (size_t)DM * DM * 2, SZ_WUP = (size_t)NUP * DM * 2, SZ_WDN = (size_t)DM * DFF * 2;
constexpr size_t OFF_WIN = 0, OFF_WUQ = OFF_WIN + al(SZ_WIN), OFF_WUKV = OFF_WUQ + al(SZ_WUQ), OFF_WOUT = OFF_WUKV + al(SZ_WUKV), OFF_WUP = OFF_WOUT + al(SZ_WOUT), OFF_WDN = OFF_WUP + al(SZ_WUP), SZ_WLAYER = OFF_WDN + al(SZ_WDN);
constexpr size_t WS_H = WS_W + 2 * SZ_WLAYER;
constexpr size_t WS_HN = WS_H + al((size_t)R * DM * 4);
constexpr size_t WS_PROJ = WS_HN + al((size_t)R * DM * 2);
constexpr size_t WS_SMALL = WS_PROJ + al((size_t)R * NPROJ * 2);
constexpr size_t WS_CQN = WS_SMALL + al((size_t)R * NSM * 4);
constexpr size_t WS_CKVN = WS_CQN + al((size_t)R * 1536 * 2);
constexpr size_t WS_KPE = WS_CKVN + al((size_t)R * 512 * 2);
constexpr size_t WS_LOGA = WS_KPE + al((size_t)R * 64 * 2);
constexpr size_t WS_LOGF = WS_LOGA + al((size_t)R * 512 * 4);
constexpr size_t WS_CF = WS_LOGF + al((size_t)R * 16 * 4);
constexpr size_t WS_QM = WS_CF + al((size_t)NB * 12 * LL * 4);
constexpr size_t WS_KVM = WS_QM + al((size_t)R * NQ * 2);
constexpr size_t WS_OG = WS_KVM + al((size_t)R * NKV * 2);
constexpr size_t WS_UB = WS_OG + al((size_t)R * DM * 4);
constexpr size_t WS_DEC = WS_UB + al((size_t)GUNITS * 128 * 256 * 4);
constexpr size_t WS_QDG = WS_DEC + al((size_t)GUNITS * 128 * 4);
constexpr size_t WS_SPT = WS_QDG + al((size_t)R * 512 * 2);
constexpr size_t WS_MIX = WS_SPT + al((size_t)GUNITS * 256 * 128 * 2);
constexpr size_t WS_EDGE = WS_MIX + al((size_t)R * DM * 2);
constexpr size_t WS_UM = WS_EDGE + al((size_t)32 * 4 * NUP * 4);
constexpr size_t WS_ACT = WS_UM + al((size_t)16 * NUP * 4);
constexpr size_t WS_WQ = WS_ACT + al((size_t)R * DFF * 2);
constexpr size_t SZ_WQ = (size_t)NUP * DM;
constexpr size_t WS_HNQ = WS_WQ + al(2 * SZ_WQ);
constexpr size_t WS_ASC = WS_HNQ + al((size_t)R * DM);
constexpr size_t WS_WSC = WS_ASC + MiB;
constexpr size_t WS_KN2 = WS_WSC + MiB;
constexpr size_t WS_KPM = WS_KN2 + al((size_t)R * 16 * 4);
constexpr size_t WS_END = WS_KPM + MiB;
constexpr int CW_BAR = 4096;
static_assert((CW_BAR + XCD_BAR_WORDS) * 4 <= (int)CTL_ZERO_BYTES, "ctl");
constexpr size_t WS_WMAX = 262144;
static_assert(WS_WMAX + 2 * NUP * 4 <= CTL_ZERO_BYTES, "wmax");
constexpr size_t WS_SS0 = 524288, WS_SS1 = 655360;
static_assert(WS_SS0 >= WS_WMAX + 2 * NUP * 4 && WS_SS0 + (size_t)R * 8 <= WS_SS1 && WS_SS1 + (size_t)R * 8 <= CTL_ZERO_BYTES, "ss");
constexpr float SS_FIX = 4294967296.0f, SS_UNFIX = 1.0f / 4294967296.0f;
constexpr int RING_BYTES = 131072, MISC_OFF = RING_BYTES, LDS_BYTES = 147456;

__device__ __forceinline__ float bf2f(bf16_t b) { return __uint_as_float(((unsigned)b) << 16); }
__device__ __forceinline__ bf16_t f2bf(float f) { unsigned u = __float_as_uint(f); u += 0x7fffu + ((u >> 16) & 1u); return (bf16_t)(u >> 16); }
__device__ __forceinline__ unsigned pk2(float lo, float hi) { return (unsigned)f2bf(lo) | ((unsigned)f2bf(hi) << 16); }
__device__ __forceinline__ float wave_sum(float v) {
#pragma unroll
    for (int o = 1; o < 64; o <<= 1) v += __shfl_xor(v, o);
    return v;
}
__device__ __forceinline__ float logsig(float x) { return fminf(x, 0.f) - log1pf(expf(-fabsf(x))); }
#define LDS_WAIT() asm volatile("s_waitcnt lgkmcnt(0)" ::: "memory")

struct Args { const float* in[21]; float* out; unsigned char* ws; int ph_lo, ph_hi; };
#define WSP(T, off) ((T*)(a.ws + (off)))

__device__ __forceinline__ int map_in(int n) {
    if (n < 2048) return n;
    if (n < 3584) return 5200 + (n - 2048);
    if (n < 5120) return 6736 + (n - 3584);
    if (n < 6656) return 8272 + (n - 5120);
    if (n < 7168) return 2112 + (n - 6656);
    if (n < 7680) return 2624 + (n - 7168);
    if (n < 8704) return 3136 + (n - 7680);
    if (n < 9728) return 4176 + (n - 8704);
    if (n < 9792) { const int j = n - 9728; return 2048 + (j & 1) * 32 + (j >> 1); }
    if (n < 9808) return 4160 + (n - 9792);
    if (n < 9820) return n;
    return -1;
}
__device__ __forceinline__ int map_uq(int n) {
    if (n < 1536) return (n >> 7) * 192 + (n & 127);
    const int j = n - 1536, h = j >> 6, jj = j & 63; return h * 192 + 128 + (jj & 1) * 32 + (jj >> 1);
}
__device__ __forceinline__ int map_up(int n) { const int pn = n >> 8, w = n & 255; return w < 128 ? 128 * pn + w : DFF + 128 * pn + (w - 128); }
__device__ __forceinline__ int map_ukv(int n) {
    if (n < 1536) return (n >> 7) * 256 + (n & 127);
    const int j = n - 1536; return (j >> 7) * 256 + 128 + (j & 127);
}
template <int MAP, int GM>
__device__ __forceinline__ void prep_item(const float* W, int Nsrc, bf16_t* WT, int K, int Ndst, const float* g0, const float* g1, const float* g2, LAS float* scr, int item, int lane, float* wmax = nullptr) {
    const int nblk = Ndst / 32, kb = item / nblk, nb = item % nblk, k0 = 128 * kb, n0 = 32 * nb;
    const int n = n0 + (lane & 31);
    const int src = MAP == 0 ? n : MAP == 1 ? map_in(n) : MAP == 2 ? map_uq(n) : MAP == 3 ? map_ukv(n) : map_up(n);
    float vv[64];
#pragma unroll
    for (int i = 0; i < 64; ++i) { const int k = k0 + 2 * i + (lane >> 5); vv[i] = src >= 0 ? W[(size_t)k * Nsrc + src] : 0.f; }
    const int c = lane & 7;
#pragma unroll
    for (int h = 0; h < 2; ++h) {
#pragma unroll
        for (int i = 0; i < 32; ++i) { const int kk = 2 * i + (lane >> 5), k = k0 + 64 * h + kk; float v = vv[32 * h + i];
            if (GM == 1) v *= g0[k];
            if (GM == 2) v *= (k < 1536 ? g0[k] : k < 2560 ? g1[k - 1536] : g2[k - 2560]);
            scr[kk * 33 + (lane & 31)] = v; }
        LDS_WAIT(); asm volatile("" ::: "memory");
#pragma unroll
        for (int j = 0; j < 4; ++j) { const int nn = (lane >> 3) + 8 * j; const LAS float* s = scr + (8 * c) * 33 + nn;
            u32x4 o; o.x = pk2(s[0 * 33], s[1 * 33]); o.y = pk2(s[2 * 33], s[3 * 33]); o.z = pk2(s[4 * 33], s[5 * 33]); o.w = pk2(s[6 * 33], s[7 * 33]);
            *(u32x4*)(WT + (size_t)(n0 + nn) * K + k0 + 64 * h + 8 * c) = o; }
        LDS_WAIT(); asm volatile("" ::: "memory");
    }
    (void)wmax;
}
__device__ const double INVF[32] = {1.0, 0.7498942093324559, 0.5623413251903491, 0.4216965034285822, 0.31622776601683794, 0.23713737056616552, 0.1778279410038923, 0.1333521432163324, 0.1, 0.07498942093324558, 0.05623413251903491, 0.042169650342858224, 0.03162277660168379, 0.023713737056616554, 0.01778279410038923, 0.01333521432163324, 0.01, 0.007498942093324558, 0.005623413251903491, 0.004216965034285823, 0.0031622776601683794, 0.0023713737056616554, 0.0017782794100389228, 0.001333521432163324, 0.001, 0.0007498942093324559, 0.0005623413251903491, 0.00042169650342858224, 0.00031622776601683794, 0.00023713737056616554, 0.00017782794100389227, 0.0001333521432163324};

__device__ __forceinline__ f32x4 bf4(unsigned lo, unsigned hi) { f32x4 r; r[0] = __uint_as_float(lo << 16); r[1] = __uint_as_float(lo & 0xffff0000u); r[2] = __uint_as_float(hi << 16); r[3] = __uint_as_float(hi & 0xffff0000u); return r; }
template <int MODE>
__device__ __forceinline__ void norm_rows(const Args& a, const float* gain, int gw, int NGW, int lane) {
    for (int row = gw; row < R; row += NGW) {
        const int b = row / LL, p = row - b * LL;
        if (MODE == 2 && p < LEAD) continue;
        f32x4 v[16];
        u32x4* hrow = (u32x4*)(WSP(bf16_t, WS_H) + (size_t)row * DM);
        if (MODE == 0) {
            const float* src = p < NPAD ? nullptr : p < LEAD ? a.in[1] + (size_t)(p - NPAD) * DM : a.in[0] + ((size_t)b * SEQ + (p - LEAD)) * DM;
#pragma unroll
            for (int j = 0; j < 16; ++j) v[j] = src ? *((const f32x4*)src + 128 * (j >> 1) + 2 * lane + (j & 1)) : (f32x4){0.f, 0.f, 0.f, 0.f};
#pragma unroll
            for (int j = 0; j < 8; ++j) { u32x4 w; w.x = pk2(v[2 * j].x, v[2 * j].y); w.y = pk2(v[2 * j].z, v[2 * j].w); w.z = pk2(v[2 * j + 1].x, v[2 * j + 1].y); w.w = pk2(v[2 * j + 1].z, v[2 * j + 1].w); hrow[64 * j + lane] = w; }
        } else {
            u32x4 q[8];
#pragma unroll
            for (int j = 0; j < 8; ++j) q[j] = hrow[64 * j + lane];
#pragma unroll
            for (int j = 0; j < 8; ++j) { v[2 * j] = bf4(q[j].x, q[j].y); v[2 * j + 1] = bf4(q[j].z, q[j].w); }
        }
        float ss = 0.f;
#pragma unroll
        for (int j = 0; j < 16; ++j) ss += (v[j].x * v[j].x + v[j].y * v[j].y) + (v[j].z * v[j].z + v[j].w * v[j].w);
        const float sst = wave_sum(ss);
        if (MODE == 0) { if (lane == 0) ((unsigned long long*)(a.ws + WS_SS0))[row] = (unsigned long long)(sst * SS_FIX); continue; }
        const float rs = 1.0f / sqrtf(sst * (1.0f / DM) + EPS);
        if (MODE == 3) {
            float am = 0.f;
#pragma unroll
            for (int j = 0; j < 16; ++j) am = fmaxf(fmaxf(am, fmaxf(fabsf(v[j].x), fabsf(v[j].y))), fmaxf(fabsf(v[j].z), fabsf(v[j].w)));
#pragma unroll
            for (int o = 1; o < 64; o <<= 1) am = fmaxf(am, __shfl_xor(am, o));
            const float qi = am > 0.f ? 127.0f / am : 0.f;
            u32x2* oq = (u32x2*)(a.ws + WS_HNQ + (size_t)row * DM);
#pragma unroll
            for (int j = 0; j < 8; ++j) { u32x2 w;
#pragma unroll
                for (int h = 0; h < 2; ++h) { const f32x4 x = v[2 * j + h]; const int q0 = (int)rintf(x.x * qi), q1 = (int)rintf(x.y * qi), q2 = (int)rintf(x.z * qi), q3 = (int)rintf(x.w * qi);
                    w[h] = (unsigned)(q0 & 255) | ((unsigned)(q1 & 255) << 8) | ((unsigned)(q2 & 255) << 16) | ((unsigned)(q3 & 255) << 24); }
                oq[64 * j + lane] = w; }
            if (lane == 0) WSP(float, WS_ASC)[row] = rs * am * (1.0f / 127.0f);
            if (p >= NPAD && p < LEAD) { u32x4* o = (u32x4*)(WSP(bf16_t, WS_HN) + (size_t)row * DM);
#pragma unroll
                for (int j = 0; j < 8; ++j) { u32x4 w; w.x = pk2(v[2 * j].x * rs, v[2 * j].y * rs); w.y = pk2(v[2 * j].z * rs, v[2 * j].w * rs); w.z = pk2(v[2 * j + 1].x * rs, v[2 * j + 1].y * rs); w.w = pk2(v[2 * j + 1].z * rs, v[2 * j + 1].w * rs); o[64 * j + lane] = w; } }
        } else if (MODE == 2) {
            float* o = a.out + ((size_t)b * SEQ + (p - LEAD)) * DM;
#pragma unroll
            for (int j = 0; j < 16; ++j) { const int idx = 128 * (j >> 1) + 2 * lane + (j & 1); const f32x4 g = *((const f32x4*)gain + idx); *((f32x4*)o + idx) = v[j] * rs * g; }
        } else {
            u32x4* o = (u32x4*)(WSP(bf16_t, WS_HN) + (size_t)row * DM);
#pragma unroll
            for (int j = 0; j < 8; ++j) { u32x4 w; w.x = pk2(v[2 * j].x * rs, v[2 * j].y * rs); w.y = pk2(v[2 * j].z * rs, v[2 * j].w * rs); w.z = pk2(v[2 * j + 1].x * rs, v[2 * j + 1].y * rs); w.w = pk2(v[2 * j + 1].z * rs, v[2 * j + 1].w * rs); o[64 * j + lane] = w; }
        }
    }
}

__device__ __forceinline__ void prep_wup_strip(const Args& a, LAS unsigned char* lds, int strip, int tid, const int wave_s) {
    const int l = strip / (NUP / 32), n0 = (strip % (NUP / 32)) * 32;
    { int t0; asm volatile("v_mbcnt_lo_u32_b32 %0, -1, 0\n\tv_mbcnt_hi_u32_b32 %0, -1, %0" : "=v"(t0)); tid = t0 + wave_s * 64; }
    const int col = tid & 31, rg = tid >> 5;
    const char* Wu = (const char*)(a.in[16] + (size_t)l * DM * NUP);
    const unsigned loff = (unsigned)(map_up(n0 + col) + 4 * rg * NUP) * 4u;
    LAS float* GL = (LAS float*)lds;
    LAS float* RED = (LAS float*)(lds + 16384);
    LAS unsigned* T = (LAS unsigned*)(lds + 16384 + 2048);
    __syncthreads();
    for (int i = tid; i < DM / 4; i += 512) ((LAS f32x4*)GL)[i] = ((const f32x4*)(a.in[15] + (size_t)l * DM))[i];
    __syncthreads();
    unsigned pk[64][2];
    float amax = 0.f;
#pragma unroll
    for (int i0 = 0; i0 < 64; i0 += 8) {
        float v[32];
#pragma unroll
        for (int j = 0; j < 32; ++j) v[j] = *(const float*)(Wu + (size_t)(64 * (i0 + (j >> 2)) + (j & 3)) * NUP * 4 + loff);
#pragma unroll
        for (int j4 = 0; j4 < 8; ++j4) { const f32x4 gg = *(const LAS f32x4*)(GL + 64 * (i0 + j4) + 4 * rg);
            const unsigned w0 = pk2(v[4 * j4] * gg[0], v[4 * j4 + 1] * gg[1]), w1 = pk2(v[4 * j4 + 2] * gg[2], v[4 * j4 + 3] * gg[3]);
            { unsigned o0 = w0, o1 = w1; asm volatile("" : "+v"(o0), "+v"(o1)); pk[i0 + j4][0] = o0; pk[i0 + j4][1] = o1; }
            amax = fmaxf(fmaxf(amax, fmaxf(fabsf(__uint_as_float(w0 << 16)), fabsf(__uint_as_float(w0 & 0xffff0000u)))), fmaxf(fabsf(__uint_as_float(w1 << 16)), fabsf(__uint_as_float(w1 & 0xffff0000u)))); }
        asm volatile("" ::: "memory");
    }
    int tq; asm volatile("v_mbcnt_lo_u32_b32 %0, -1, 0\n\tv_mbcnt_hi_u32_b32 %0, -1, %0" : "=v"(tq)); tq += wave_s * 64;
    const int col2 = tq & 31, rg2 = tq >> 5;
    RED[rg2 * 32 + col2] = amax;
    __syncthreads();
    float am = 0.f;
#pragma unroll
    for (int r = 0; r < 16; ++r) am = fmaxf(am, RED[r * 32 + col2]);
    const float qi = am > 0.f ? 127.0f / am : 0.f;
    if (rg2 == 0) WSP(float, WS_WSC)[(size_t)l * NUP + n0 + col2] = am * (1.0f / 127.0f);
    char* WQ = (char*)(a.ws + WS_WQ + (size_t)l * SZ_WQ + (size_t)n0 * DM);
    const unsigned woff = (unsigned)((tq >> 4) * DM + 16 * (tq & 15)), tw = (unsigned)(col2 * 65 + rg2), tr = (unsigned)((tq >> 4) * 65 + 4 * (tq & 15));
#pragma unroll
    for (int c = 0; c < 16; ++c) {
        LAS unsigned* Tb = T + (c & 1) * (32 * 65);
#pragma unroll
        for (int ii = 0; ii < 4; ++ii) { const unsigned w0 = pk[4 * c + ii][0], w1 = pk[4 * c + ii][1];
            const int q0 = (int)rintf(__uint_as_float(w0 << 16) * qi), q1 = (int)rintf(__uint_as_float(w0 & 0xffff0000u) * qi), q2 = (int)rintf(__uint_as_float(w1 << 16) * qi), q3 = (int)rintf(__uint_as_float(w1 & 0xffff0000u) * qi);
            Tb[tw + 16 * ii] = (unsigned)(q0 & 255) | ((unsigned)(q1 & 255) << 8) | ((unsigned)(q2 & 255) << 16) | ((unsigned)(q3 & 255) << 24); }
        __syncthreads();
        { const LAS unsigned* s = Tb + tr; u32x4 w; w.x = s[0]; w.y = s[1]; w.z = s[2]; w.w = s[3];
          *(u32x4*)(WQ + woff + 256 * c) = w; }
    }
}
__device__ __forceinline__ void phase_prologue(const Args& a, LAS unsigned char* lds, int tid, int lane, int wave) {
    LAS float* scr = (LAS float*)(lds + wave * 16384);
    const int gw = blockIdx.x * 8 + wave, NGW = gridDim.x * 8;
    constexpr int I_IN = (DM / 128) * (NIN / 32), I_UQ = (1536 / 128) * (NQ / 32), I_UKV = (512 / 128) * (NKV / 32), I_OUT = (DM / 128) * (DM / 32), I_DN = (DFF / 128) * (DM / 32);
    static_assert(DFF % 128 == 0 && 1536 % 128 == 0, "item k extent");
    constexpr int I_LAYER = I_IN + I_UQ + I_UKV + I_OUT + I_DN;
    for (int it = gw; it < 2 * I_LAYER; it += NGW) {
        const int l = it / I_LAYER; int r = it - l * I_LAYER;
        unsigned char* wb = a.ws + WS_W + (size_t)l * SZ_WLAYER;
        if (r < I_IN) { prep_item<1, 1>(a.in[3] + (size_t)l * DM * 9820, 9820, (bf16_t*)(wb + OFF_WIN), DM, NIN, a.in[2] + l * DM, nullptr, nullptr, scr, r, lane); continue; } r -= I_IN;
        if (r < I_UQ) { prep_item<2, 1>(a.in[5] + (size_t)l * 1536 * 2304, 2304, (bf16_t*)(wb + OFF_WUQ), 1536, NQ, a.in[4] + l * 1536, nullptr, nullptr, scr, r, lane); continue; } r -= I_UQ;
        if (r < I_UKV) { prep_item<3, 1>(a.in[7] + (size_t)l * 512 * 3072, 3072, (bf16_t*)(wb + OFF_WUKV), 512, NKV, a.in[6] + l * 512, nullptr, nullptr, scr, r, lane); continue; } r -= I_UKV;
        if (r < I_OUT) { prep_item<0, 2>(a.in[14] + (size_t)l * DM * DM, DM, (bf16_t*)(wb + OFF_WOUT), DM, DM, a.in[11] + l * 1536, a.in[12] + l * 1024, a.in[13] + l * 1536, scr, r, lane); continue; } r -= I_OUT;
        prep_item<0, 0>(a.in[19] + (size_t)l * DFF * DM, DM, (bf16_t*)(wb + OFF_WDN), DFF, DM, nullptr, nullptr, nullptr, scr, r, lane);
    }
    for (int e = blockIdx.x * 512 + tid; e < LL * 32; e += gridDim.x * 512) {
        const int p = e >> 5, i = e & 31; const int pos = p > NPAD ? p - NPAD : 0;
        const double ang = (double)pos * INVF[i]; const double kr = rint(ang * 0.15915494309189535); const float rr = (float)(ang - kr * 6.283185307179586);
        WSP(float, WS_CS)[2 * e] = cosf(rr); WSP(float, WS_CS)[2 * e + 1] = sinf(rr);
    }
    norm_rows<0>(a, nullptr, gw, NGW, lane);
}

__device__ __forceinline__ void phase_wquant(const Args& a, int layer, int gw, int NGW, int lane) {
    const bf16_t* Wt = (const bf16_t*)(a.ws + WS_W + (size_t)layer * SZ_WLAYER + OFF_WUP); const float* wmax = (const float*)(a.ws + WS_WMAX) + (size_t)layer * NUP;
    unsigned char* WQ = a.ws + WS_WQ + (size_t)layer * SZ_WQ; float* wsc = WSP(float, WS_WSC) + (size_t)layer * NUP;
    for (int n = gw; n < NUP; n += NGW) {
        const float am = wmax[n], qi = am > 0.f ? 127.0f / am : 0.f;
        if (lane == 0) wsc[n] = am * (1.0f / 127.0f);
#pragma unroll
        for (int j = 0; j < 8; ++j) { const int c = lane + 64 * j; const bf16x8 raw = *(const bf16x8*)(Wt + (size_t)n * DM + c * 8); unsigned w0 = 0u, w1 = 0u;
#pragma unroll
            for (int e = 0; e < 4; ++e) { const int q = (int)rintf(bf2f((bf16_t)raw[e]) * qi); w0 |= (unsigned)(q & 255) << (8 * e); }
#pragma unroll
            for (int e = 0; e < 4; ++e) { const int q = (int)rintf(bf2f((bf16_t)raw[4 + e]) * qi); w1 |= (unsigned)(q & 255) << (8 * e); }
            u32x2 w; w.x = w0; w.y = w1; *(u32x2*)(WQ + (size_t)n * DM + c * 8) = w; }
    }
}

__device__ __forceinline__ void phase_prep_rows(const Args& a, int layer, int gw, int NGW, int lane_in) {
    const float* W2 = a.in[8] + (size_t)layer * 16 * 512; const float* bG = a.in[9] + layer * 512; const float* bF = a.in[10] + layer * 12;
    for (int row = gw; row < R; row += NGW) {
        const int p = row % LL; const bool valid = p >= NPAD;
        int lane = lane_in; asm volatile("" : "+v"(lane));
        const bf16_t* pr = WSP(bf16_t, WS_PROJ) + (size_t)row * NPROJ;
        const float* sm = WSP(float, WS_SMALL) + (size_t)row * NSM;
        bf16x8 rq[3], rk[3];
#pragma unroll
        for (int j = 0; j < 3; ++j) rq[j] = *(const bf16x8*)(pr + (lane + 64 * j) * 8);
        const bf16x8 rkv = *(const bf16x8*)(pr + 1536 + lane * 8);
#pragma unroll
        for (int j = 0; j < 3; ++j) rk[j] = *(const bf16x8*)(pr + PC_FK + (lane + 64 * j) * 8);
        const int l32 = lane & 31;
        const float x1 = sm[2 * l32], x2 = sm[2 * l32 + 1], cc = WSP(float, WS_CS)[((size_t)p * 32 + l32) * 2], sn = WSP(float, WS_CS)[((size_t)p * 32 + l32) * 2 + 1];
        f32x4 gzv[4];
#pragma unroll
        for (int j = 0; j < 4; ++j) gzv[j] = *(const f32x4*)(sm + 64 + 4 * j);
        const float zf = sm[80 + (lane < 12 ? lane : 0)] + bF[lane < 12 ? lane : 0];
        u32x4 wq[3];
        { float x[3][8]; float ss = 0.f;
#pragma unroll
            for (int j = 0; j < 3; ++j)
#pragma unroll
                for (int e = 0; e < 8; ++e) { x[j][e] = bf2f((bf16_t)rq[j][e]); ss += x[j][e] * x[j][e]; }
            const float rs = 1.0f / sqrtf(wave_sum(ss) * (1.0f / 1536.f) + EPS);
#pragma unroll
            for (int j = 0; j < 3; ++j) { wq[j].x = pk2(x[j][0] * rs, x[j][1] * rs); wq[j].y = pk2(x[j][2] * rs, x[j][3] * rs); wq[j].z = pk2(x[j][4] * rs, x[j][5] * rs); wq[j].w = pk2(x[j][6] * rs, x[j][7] * rs); } }
        u32x4 wkv;
        { float x[8]; float ss = 0.f;
#pragma unroll
            for (int e = 0; e < 8; ++e) { x[e] = bf2f((bf16_t)rkv[e]); ss += x[e] * x[e]; }
            const float rs = 1.0f / sqrtf(wave_sum(ss) * (1.0f / 512.f) + EPS);
            wkv.x = pk2(x[0] * rs, x[1] * rs); wkv.y = pk2(x[2] * rs, x[3] * rs); wkv.z = pk2(x[4] * rs, x[5] * rs); wkv.w = pk2(x[6] * rs, x[7] * rs); }
        const unsigned kpe = pk2(x1 * cc - x2 * sn, x2 * cc + x1 * sn);
        f32x4 o0, o1;
        { float acc[8];
            { const f32x4 b0 = *(const f32x4*)(bG + lane * 8), b1 = *(const f32x4*)(bG + lane * 8 + 4); acc[0] = b0.x; acc[1] = b0.y; acc[2] = b0.z; acc[3] = b0.w; acc[4] = b1.x; acc[5] = b1.y; acc[6] = b1.z; acc[7] = b1.w; }
#pragma unroll
            for (int j = 0; j < 16; ++j) { if ((j & 3) == 0) asm volatile("" ::: "memory");
                const float gz = gzv[j >> 2][j & 3]; const f32x4 w0 = *(const f32x4*)(W2 + j * 512 + lane * 8), w1 = *(const f32x4*)(W2 + j * 512 + lane * 8 + 4);
                acc[0] += gz * w0.x; acc[1] += gz * w0.y; acc[2] += gz * w0.z; acc[3] += gz * w0.w; acc[4] += gz * w1.x; acc[5] += gz * w1.y; acc[6] += gz * w1.z; acc[7] += gz * w1.w; }
            o0.x = valid ? logsig(acc[0]) * 0.0625f : 0.f; o0.y = valid ? logsig(acc[1]) * 0.0625f : 0.f; o0.z = valid ? logsig(acc[2]) * 0.0625f : 0.f; o0.w = valid ? logsig(acc[3]) * 0.0625f : 0.f;
            o1.x = valid ? logsig(acc[4]) * 0.0625f : 0.f; o1.y = valid ? logsig(acc[5]) * 0.0625f : 0.f; o1.z = valid ? logsig(acc[6]) * 0.0625f : 0.f; o1.w = valid ? logsig(acc[7]) * 0.0625f : 0.f; }
        const float lf = valid ? logsig(zf) : 0.f;
        float kn[3];
#pragma unroll
        for (int j = 0; j < 3; ++j) { float ss = 0.f;
#pragma unroll
            for (int e = 0; e < 8; ++e) { const float x = bf2f((bf16_t)rk[j][e]); ss += x * x; }
            ss += __shfl_xor(ss, 1); ss += __shfl_xor(ss, 2); ss += __shfl_xor(ss, 4); ss += __shfl_xor(ss, 8); kn[j] = ss; }
#pragma unroll
        for (int j = 0; j < 3; ++j) *(u32x4*)(WSP(bf16_t, WS_CQN) + (size_t)row * 1536 + (lane + 64 * j) * 8) = wq[j];
        *(u32x4*)(WSP(bf16_t, WS_CKVN) + (size_t)row * 512 + lane * 8) = wkv;
        if (lane < 32) *(unsigned*)(WSP(bf16_t, WS_KPE) + (size_t)row * 64 + 2 * lane) = kpe;
        *(f32x4*)(WSP(float, WS_LOGA) + (size_t)row * 512 + lane * 8) = o0; *(f32x4*)(WSP(float, WS_LOGA) + (size_t)row * 512 + lane * 8 + 4) = o1;
        if (lane < 12) WSP(float, WS_LOGF)[(size_t)row * 16 + lane] = lf;
        if ((lane & 15) == 0) {
#pragma unroll
            for (int j = 0; j < 3; ++j) WSP(float, WS_KN2)[(size_t)row * 16 + 4 * j + (lane >> 4)] = kn[j]; }
    }
}
__device__ __forceinline__ void phase_fcum(const Args& a, int gw, int lane) {
    const int G = gridDim.x; int seq;
    if (G >= 128) { if ((gw & 7) != 0 || (gw >> 3) < 96 || (gw >> 3) >= 96 + NB * 12) return; seq = (gw >> 3) - 96; }
    else { if (gw >= NB * 12) return; seq = gw; }
    const int b = seq / 12, h = seq % 12; constexpr int PER = LL / 64;
    const float* src = WSP(float, WS_LOGF) + ((size_t)b * LL + lane * PER) * 16 + h;
    float v[PER]; float s = 0.f;
#pragma unroll
    for (int i = 0; i < PER; ++i) v[i] = src[(size_t)i * 16];
#pragma unroll
    for (int i = 0; i < PER; ++i) s += v[i];
    float incl = s;
#pragma unroll
    for (int o = 1; o < 64; o <<= 1) { const float t = __shfl_up(incl, o); if (lane >= o) incl += t; }
    float run = incl - s;
    float* dst = WSP(float, WS_CF) + ((size_t)b * 12 + h) * LL + lane * PER;
#pragma unroll
    for (int i = 0; i < PER; ++i) { run += v[i]; dst[i] = run; }
#pragma unroll
    for (int t = 0; t < PER; ++t) { const int p = 64 * t + lane; v[t] = p >= NPAD ? WSP(const float, WS_KN2)[((size_t)b * LL + p) * 16 + h] : 0.f; }
    float pm = 0.f;
#pragma unroll
    for (int t = 0; t < PER; ++t) { float x = v[t];
#pragma unroll
        for (int o = 1; o < 64; o <<= 1) x = fmaxf(x, __shfl_xor(x, o));
        pm = fmaxf(pm, x); if (lane == 0) WSP(float, WS_KPM)[(size_t)seq * PER + t] = sqrtf(pm); }
}

__device__ __forceinline__ f32x4 mma16(const LAS bf16_t* A, int lda, const LAS bf16_t* Bt, int ldb, int K, int lane, f32x4 acc) {
    const LAS bf16_t* a = A + (lane & 15) * lda + 8 * (lane >> 4);
    const LAS bf16_t* b = Bt + (lane & 15) * ldb + 8 * (lane >> 4);
    for (int k0 = 0; k0 < K; k0 += 32) acc = __builtin_amdgcn_mfma_f32_16x16x32_bf16(*(const LAS bf16x8*)(a + k0), *(const LAS bf16x8*)(b + k0), acc, 0, 0, 0);
    return acc;
}

struct SkEmit { int mode; bf16_t* O; int ldo; int nbf_cols; float* F; int ldf; int rope_from; const float* cs; bf16_t* H; const unsigned long long* rss; unsigned long long* ssq; };
__device__ __forceinline__ void sk_emit(const SkEmit& e, int r, int col, float v, int lane) {
    if (e.mode == 3) { e.F[(size_t)r * e.ldf + col] = v; return; }
    if (e.mode == 2) { bf16_t* p0 = e.H + (size_t)(NPAD + r) * DM + col; const bf16_t nv = f2bf(bf2f(*p0) + v); *p0 = nv; p0[(size_t)LL * DM] = nv;
        if (e.ssq) { float s2 = bf2f(nv) * bf2f(nv); s2 += __shfl_xor(s2, 1); s2 += __shfl_xor(s2, 2); s2 += __shfl_xor(s2, 4); s2 += __shfl_xor(s2, 8);
            if ((lane & 15) == 0) { const unsigned long long q = (unsigned long long)(s2 * SS_FIX); atomicAdd(e.ssq + NPAD + r, q); atomicAdd(e.ssq + LL + NPAD + r, q); } }
        return; }
    if (e.rss) v *= 1.0f / sqrtf((float)e.rss[NPAD + r] * (SS_UNFIX / DM) + EPS);
    if (col >= e.rope_from) { const float o = __shfl_xor(v, 1); const int i = (col & 63) >> 1; const float* t = e.cs + ((size_t)(NPAD + r) * 32 + i) * 2; const float c = t[0], s = t[1];
        v = (lane & 1) ? (v * c + o * s) : (v * c - o * s); }
    if (col < e.nbf_cols) { const bf16_t w = f2bf(v); bf16_t* p0 = e.O + (size_t)(NPAD + r) * e.ldo + col; *p0 = w; p0[(size_t)LL * e.ldo] = w; }
    else { float* p0 = e.F + (size_t)(NPAD + r) * e.ldf + (col - e.nbf_cols); *p0 = v; p0[(size_t)LL * e.ldf] = v; }
}
__device__ __forceinline__ void skinny_gemm(const bf16_t* A, const bf16_t* Wt, int N, int K, int nunits, const SkEmit& e, LAS unsigned char* lds, int lane, int wave) {
    const int G = gridDim.x, rem = nunits % G;
    const int first = ((int)blockIdx.x - rem + G) % G;
    const int ql = lane & 15, quad = lane >> 4, kw = K >> 3, nsteps = kw >> 5;
    LAS f32x4* red = (LAS f32x4*)lds;
    const bf16_t* ap = A + (size_t)(NPAD + ql) * K + wave * kw + 8 * quad;
    for (int ct = first; ct < (N >> 4); ct += G) {
        const bf16_t* bp = Wt + (size_t)(16 * ct + ql) * K + wave * kw + 8 * quad;
        f32x4 acc = {0.f, 0.f, 0.f, 0.f};
        for (int s0 = 0; s0 < nsteps; s0 += 16) {
            bf16x8 af[16], bf[16];
#pragma unroll
            for (int s = 0; s < 16; ++s) if (s0 + s < nsteps) { af[s] = *(const bf16x8*)(ap + (s0 + s) * 32); bf[s] = *(const bf16x8*)(bp + (s0 + s) * 32); }
#pragma unroll
            for (int s = 0; s < 16; ++s) if (s0 + s < nsteps) acc = __builtin_amdgcn_mfma_f32_16x16x32_bf16(af[s], bf[s], acc, 0, 0, 0);
        }
        red[wave * 64 + lane] = acc;
        __syncthreads();
        if (wave == 0) {
            f32x4 s = red[lane];
#pragma unroll
            for (int w = 1; w < 8; ++w) s = s + red[w * 64 + lane];
#pragma unroll
            for (int reg = 0; reg < 4; ++reg) sk_emit(e, quad * 4 + reg, 16 * ct + ql, s[reg], lane);
        }
        __syncthreads();
    }
}

__device__ __forceinline__ void skinny_gemm_i8(const unsigned char* Aq, const unsigned char* Wq, int N, int nunits, const float* asc, const float* wsc, const SkEmit& e, LAS unsigned char* lds, int lane, int wave) {
    typedef int i32x4_t __attribute__((ext_vector_type(4)));
    const int G = gridDim.x, rem = nunits % G;
    const int first = ((int)blockIdx.x - rem + G) % G;
    const int ql = lane & 15, quad = lane >> 4;
    LAS f32x4* red = (LAS f32x4*)lds;
    if (first >= (N >> 4)) return;
    const unsigned char* ap = Aq + (size_t)(NPAD + ql) * DM + wave * (DM / 8) + 16 * quad;
    for (int ct = first; ct < (N >> 4); ct += G) {
        const unsigned char* bp = Wq + (size_t)(16 * ct + ql) * DM + wave * (DM / 8) + 16 * quad;
        i32x4_t av[8], bv[8], acc = {0, 0, 0, 0};
#pragma unroll
        for (int s = 0; s < 8; ++s) { av[s] = *(const i32x4_t*)(ap + 64 * s); bv[s] = *(const i32x4_t*)(bp + 64 * s); }
#pragma unroll
        for (int s = 0; s < 8; ++s) acc = __builtin_amdgcn_mfma_i32_16x16x64_i8(av[s], bv[s], acc, 0, 0, 0);
        f32x4 f; f[0] = (float)acc[0]; f[1] = (float)acc[1]; f[2] = (float)acc[2]; f[3] = (float)acc[3];
        red[wave * 64 + lane] = f;
        __syncthreads();
        if (wave == 0) {
            f32x4 s = red[lane];
#pragma unroll
            for (int w = 1; w < 8; ++w) s = s + red[w * 64 + lane];
            const float cs_ = wsc[16 * ct + ql];
#pragma unroll
            for (int reg = 0; reg < 4; ++reg) sk_emit(e, quad * 4 + reg, 16 * ct + ql, s[reg] * cs_ * asc[NPAD + quad * 4 + reg], lane);
        }
        __syncthreads();
    }
}

__device__ __forceinline__ void phase_gla_b1(const Args& a, LAS unsigned char* lds, int tid, int lane, int wave) {
    LAS float* LA = (LAS float*)lds;
    LAS bf16_t* AM = (LAS bf16_t*)lds;
    LAS bf16_t* QD = (LAS bf16_t*)(lds + 32768);
    LAS bf16_t* KD = (LAS bf16_t*)(lds + 32768 + 17408);
    LAS bf16_t* KST = (LAS bf16_t*)(lds + 32768 + 2 * 17408);
    LAS bf16_t* VT = (LAS bf16_t*)(lds + 32768 + 2 * 17408 + 18432);
    const f32x4 zero = {0.f, 0.f, 0.f, 0.f};
    for (int u = (int)(gridDim.x - 1 - blockIdx.x); u < GUNITS; u += gridDim.x) {
        const int b = u / (4 * GCH), h = (u / GCH) & 3, n = u % GCH; const int r0 = b * LL + 64 * n;
        f32x4 la[4]; bf16x8 qraw_[2], kraw_[2], vraw_[4];
#pragma unroll
        for (int i = 0; i < 4; ++i) { const int idx = tid + 512 * i, t = idx >> 5, k4 = (idx & 31) * 4; la[i] = *(const f32x4*)(WSP(float, WS_LOGA) + (size_t)(r0 + t) * 512 + h * 128 + k4); }
#pragma unroll
        for (int i = 0; i < 2; ++i) { const int idx = tid + 512 * i, t = idx >> 4, k0 = (idx & 15) * 8; const size_t pr = (size_t)(r0 + t) * NPROJ;
            qraw_[i] = *(const bf16x8*)(WSP(const bf16_t, WS_PROJ) + pr + PC_GQ + h * 128 + k0); kraw_[i] = *(const bf16x8*)(WSP(const bf16_t, WS_PROJ) + pr + PC_GK + h * 128 + k0); }
#pragma unroll
        for (int i = 0; i < 4; ++i) { const int idx = tid + 512 * i, t = idx >> 5, j0 = (idx & 31) * 8; vraw_[i] = *(const bf16x8*)(WSP(const bf16_t, WS_PROJ) + (size_t)(r0 + t) * NPROJ + PC_GV + h * 256 + j0); }
#pragma unroll
        for (int i = 0; i < 4; ++i) { const int idx = tid + 512 * i, t = idx >> 5, k4 = (idx & 31) * 4; *(LAS f32x4*)(LA + t * 128 + k4) = la[i]; }
        __syncthreads();
        {
            const int k = tid & 127, part = tid >> 7; float v[16]; float run = 0.f;
#pragma unroll
            for (int i = 0; i < 16; ++i) { run += LA[(16 * part + i) * 128 + k]; v[i] = run; }
#pragma unroll
            for (int i = 0; i < 16; ++i) LA[(16 * part + i) * 128 + k] = v[i];
            __syncthreads();
            float off = 0.f;
#pragma unroll
            for (int p = 0; p < 3; ++p) if (p < part) off += LA[(16 * p + 15) * 128 + k];
            __syncthreads();
#pragma unroll
            for (int i = 0; i < 16; ++i) LA[(16 * part + i) * 128 + k] = v[i] + off;
        }
        __syncthreads();
#pragma unroll
        for (int i = 0; i < 2; ++i) { const int idx = tid + 512 * i, t = idx >> 4, k0 = (idx & 15) * 8;
            const bool vf = (64 * n + t) >= NPAD;
            const bf16x8 qraw = qraw_[i], kraw = kraw_[i];
            const f32x4 b0 = *(const LAS f32x4*)(LA + t * 128 + k0), b1 = *(const LAS f32x4*)(LA + t * 128 + k0 + 4), l0 = *(const LAS f32x4*)(LA + 63 * 128 + k0), l1 = *(const LAS f32x4*)(LA + 63 * 128 + k0 + 4);
            float qd[8], kd[8];
#pragma unroll
            for (int e = 0; e < 8; ++e) { const float bb = e < 4 ? b0[e & 3] : b1[e & 3], bl = e < 4 ? l0[e & 3] : l1[e & 3];
                const float q = bf2f((bf16_t)qraw[e]) * 0.08838834764831845f, kk = vf ? bf2f((bf16_t)kraw[e]) : 0.f;
                qd[e] = q * __expf(bb); kd[e] = kk * __expf(-bb); KST[(k0 + e) * 72 + t] = f2bf(kk * __expf(bl - bb)); }
            u32x4 wq, wk; wq.x = pk2(qd[0], qd[1]); wq.y = pk2(qd[2], qd[3]); wq.z = pk2(qd[4], qd[5]); wq.w = pk2(qd[6], qd[7]); wk.x = pk2(kd[0], kd[1]); wk.y = pk2(kd[2], kd[3]); wk.z = pk2(kd[4], kd[5]); wk.w = pk2(kd[6], kd[7]);
            *(LAS u32x4*)(QD + t * 136 + k0) = wq; *(LAS u32x4*)(KD + t * 136 + k0) = wk;
            *(u32x4*)(WSP(bf16_t, WS_QDG) + (size_t)(r0 + t) * 512 + h * 128 + k0) = wq;
            if (t == 63) { f32x4 d0, d1; d0[0] = __expf(l0[0]); d0[1] = __expf(l0[1]); d0[2] = __expf(l0[2]); d0[3] = __expf(l0[3]); d1[0] = __expf(l1[0]); d1[1] = __expf(l1[1]); d1[2] = __expf(l1[2]); d1[3] = __expf(l1[3]);
                *(f32x4*)(WSP(float, WS_DEC) + (size_t)u * 128 + k0) = d0; *(f32x4*)(WSP(float, WS_DEC) + (size_t)u * 128 + k0 + 4) = d1; } }
#pragma unroll
        for (int i = 0; i < 4; ++i) { const int idx = tid + 512 * i, t = idx >> 5, j0 = (idx & 31) * 8; const bf16x8 raw = vraw_[i];
#pragma unroll
            for (int e = 0; e < 8; ++e) VT[(j0 + e) * 72 + t] = (bf16_t)raw[e]; }
        __syncthreads();
        f32x4 a2[2];
#pragma unroll
        for (int q = 0; q < 2; ++q) { const int id = wave * 2 + q, tm = id >> 2, tn = id & 3; a2[q] = mma16(QD + 16 * tm * 136, 136, KD + 16 * tn * 136, 136, 128, lane, zero); }
#pragma unroll
        for (int q = 0; q < 2; ++q) { const int id = wave * 2 + q, tm = id >> 2, tn = id & 3;
#pragma unroll
            for (int reg = 0; reg < 4; ++reg) { const int t = 16 * tm + (lane >> 4) * 4 + reg, s = 16 * tn + (lane & 15); AM[t * 72 + s] = f2bf(s <= t ? a2[q][reg] : 0.f); } }
        __syncthreads();
#pragma unroll 2
        for (int q = 0; q < 8; ++q) { const int id = wave * 8 + q, tm = id >> 4, tn = id & 15; const f32x4 o = mma16(VT + 16 * tn * 72, 72, AM + 16 * tm * 72, 72, 64, lane, zero);
            u32x2 w; w.x = pk2(o[0], o[1]); w.y = pk2(o[2], o[3]); *(u32x2*)(WSP(bf16_t, WS_OG) + (size_t)(r0 + 16 * tm + (lane & 15)) * 1024 + h * 256 + 16 * tn + (lane >> 4) * 4) = w; }
#pragma unroll 2
        for (int q = 0; q < 16; ++q) { const int id = wave * 16 + q, tm = id >> 4, tn = id & 15; const f32x4 o = mma16(KST + 16 * tm * 72, 72, VT + 16 * tn * 72, 72, 64, lane, zero);
            u32x2 w; w.x = pk2(o[0], o[1]); w.y = pk2(o[2], o[3]); *(u32x2*)(WSP(bf16_t, WS_UB) + ((size_t)u * 256 + 16 * tn + (lane & 15)) * 128 + 16 * tm + (lane >> 4) * 4) = w; }
        __syncthreads();
    }
}
__device__ __forceinline__ void phase_gla_b2(const Args& a, int tid) {
    const bf16_t* __restrict__ UB = WSP(const bf16_t, WS_UB); const float* __restrict__ DEC = WSP(const float, WS_DEC); bf16_t* __restrict__ SPT = WSP(bf16_t, WS_SPT);
    for (int gid = blockIdx.x * 512 + tid; gid < NB * 4 * 256 * 32; gid += gridDim.x * 512) {
        const int bh = gid >> 13, j = (gid >> 5) & 255, kg = gid & 31; float S0 = 0.f, S1 = 0.f, S2 = 0.f, S3 = 0.f;
#pragma unroll 22
        for (int n = 0; n < GCH; ++n) { const size_t u = (size_t)bh * GCH + n; const size_t o = (u * 256 + j) * 128 + kg * 4; const f32x4 d = *(const f32x4*)(DEC + u * 128 + kg * 4);
            const u32x2 x = *(const u32x2*)(UB + o);
            u32x2 w; w.x = pk2(S0, S1); w.y = pk2(S2, S3); *(u32x2*)(SPT + o) = w;
            S0 = S0 * d.x + __uint_as_float(x.x << 16); S1 = S1 * d.y + __uint_as_float(x.x & 0xffff0000u); S2 = S2 * d.z + __uint_as_float(x.y << 16); S3 = S3 * d.w + __uint_as_float(x.y & 0xffff0000u); }
    }
}
__device__ __forceinline__ void phase_gla_b3(const Args& a, LAS unsigned char* lds, int tid, int lane, int wave) {
    LAS bf16_t* ST = (LAS bf16_t*)lds;
    LAS bf16_t* QD = (LAS bf16_t*)(lds + 69632);
    LAS float* PS = (LAS float*)(lds + 69632 + 17408);
    const f32x4 zero = {0.f, 0.f, 0.f, 0.f};
    const int ql = lane & 15, quad = lane >> 4, tm = wave >> 1, cb0 = (wave & 1) * 128;
    for (int u = blockIdx.x; u < GUNITS; u += gridDim.x) {
        const int b = u / (4 * GCH), h = (u / GCH) & 3, n = u % GCH; const int r0 = b * LL + 64 * n;
#pragma unroll
        for (int i = 0; i < 8; ++i) { const int idx = tid + 512 * i, j = idx >> 4, ch = idx & 15; *(LAS bf16x8*)(ST + j * 136 + ch * 8) = *(const bf16x8*)(WSP(const bf16_t, WS_SPT) + ((size_t)u * 256 + j) * 128 + ch * 8); }
#pragma unroll
        for (int i = 0; i < 2; ++i) { const int idx = tid + 512 * i, t = idx >> 4, ch = idx & 15; *(LAS bf16x8*)(QD + t * 136 + ch * 8) = *(const bf16x8*)(WSP(bf16_t, WS_QDG) + (size_t)(r0 + t) * 512 + h * 128 + ch * 8); }
        const int t = 16 * tm + ql;
        u32x2 gr[8];
        { const bf16_t* gp = WSP(const bf16_t, WS_PROJ) + (size_t)(r0 + t) * NPROJ + PC_GR + h * 256 + cb0 + quad * 4;
#pragma unroll
          for (int q = 0; q < 8; ++q) gr[q] = *(const u32x2*)(gp + 16 * q); }
        __syncthreads();
        f32x4 o[8]; float ss = 0.f;
#pragma unroll
        for (int q = 0; q < 8; ++q) { o[q] = mma16(ST + (cb0 + 16 * q) * 136, 136, QD + 16 * tm * 136, 136, 128, lane, zero);
            const u32x2 g = *(const u32x2*)(WSP(const bf16_t, WS_OG) + (size_t)(r0 + t) * 1024 + h * 256 + cb0 + 16 * q + quad * 4);
            o[q][0] += __uint_as_float(g.x << 16); o[q][1] += __uint_as_float(g.x & 0xffff0000u); o[q][2] += __uint_as_float(g.y << 16); o[q][3] += __uint_as_float(g.y & 0xffff0000u);
            ss += (o[q][0] * o[q][0] + o[q][1] * o[q][1]) + (o[q][2] * o[q][2] + o[q][3] * o[q][3]); }
        ss += __shfl_xor(ss, 16); ss += __shfl_xor(ss, 32);
        if (quad == 0) PS[wave * 16 + ql] = ss;
        __syncthreads();
        { const float tot = PS[wave * 16 + ql] + PS[(wave ^ 1) * 16 + ql];
            const float rs = 1.0f / sqrtf(tot * (1.0f / 256.f) + EPS);
            bf16_t* op = WSP(bf16_t, WS_MIX) + (size_t)(r0 + t) * DM + 1536 + h * 256 + cb0 + quad * 4;
#pragma unroll
            for (int q = 0; q < 8; ++q) { float y[4];
#pragma unroll
                for (int e4 = 0; e4 < 4; ++e4) { const unsigned gw_ = e4 < 2 ? gr[q].x : gr[q].y; const float g = __uint_as_float((e4 & 1) ? (gw_ & 0xffff0000u) : (gw_ << 16));
                    y[e4] = o[q][e4] * rs * (g * __builtin_amdgcn_rcpf(1.0f + __expf(-g))); }
                u32x2 w; w.x = pk2(y[0], y[1]); w.y = pk2(y[2], y[3]); *(u32x2*)(op + 16 * q) = w; } }
        __syncthreads();
    }
}


namespace att {
typedef short s16x4 __attribute__((ext_vector_type(4)));
typedef float f32x16 __attribute__((ext_vector_type(16)));
constexpr int SHM_K = 16384, SHM_V = 16384, SHM_KP = 8192;
constexpr int OFF_V = 0, OFF_K = 2 * SHM_V, OFF_KP = OFF_K + 2 * SHM_K, OFF_BIAS = OFF_KP + 2 * SHM_KP, OFF_WS = OFF_BIAS + 512, OFF_VOTE = OFF_WS + 8 * 64 * 4, ATT_LDS = OFF_VOTE + 64;
static_assert(ATT_LDS <= RING_BYTES, "attention LDS");
constexpr float LOG2E = 1.4426950408889634f, THR2 = 8.f * 1.4426950408889634f;
#define ATT_KSWZ(row, colB) ((row) * 256 + ((colB) ^ (((row) & 15) << 4)))
#define ATT_KPSWZ(row, colB) ((row) * 128 + ((colB) ^ ((((row) >> 1) & 7) << 4)))
#define ATT_SBAR() __builtin_amdgcn_sched_barrier(0)
__device__ __forceinline__ int v_st(int k, int c) { const int kk = (k & ~0xC) | ((k & 4) << 1) | ((k & 8) >> 1); return ((kk >> 3) * 4 + (c >> 5)) * 512 + ((kk & 7) * 32 + (c & 31)) * 2; }
__device__ __forceinline__ int v_rd_base(int lane) { return ((lane & 3) << 3) | (((lane >> 2) & 3) << 6) | (((lane >> 4) & 1) << 5) | (((lane >> 5) & 1) << 8); }
constexpr int v_rd_off(int d0, int ks, int half) { return d0 * 512 + ks * 4096 + half * 2048; }
__device__ __forceinline__ int crow(int r, int hi) { return (r & 3) + 8 * (r >> 2) + 4 * hi; }
__device__ __forceinline__ unsigned cvtpk(float lo, float hi) { unsigned r; asm volatile("v_cvt_pk_bf16_f32 %0, %1, %2" : "=v"(r) : "v"(lo), "v"(hi)); return r; }

template <int KB, int TYPE>
__device__ __forceinline__ void qkt(f32x16& p0, f32x16& p1, const LAS char* lds, int r32, int hi, const bf16x8* qr, const bf16x8* qpe) {
    p0 = f32x16{}; p1 = f32x16{};
    int ko[4];
#pragma unroll
    for (int dd = 0; dd < 4; ++dd) ko[dd] = ATT_KSWZ(r32, (dd * 16 + hi * 8) * 2);
    int kx = 128; asm volatile("" : "+v"(kx));
    constexpr int NS = TYPE == 0 ? 12 : 8;
    bf16x8 c0, c1, n0, n1;
#define ATT_KRD(s_, x0, x1) do { if ((s_) < 8) { const LAS char* ka = lds + OFF_K + KB * SHM_K + ((s_) < 4 ? ko[(s_) & 3] : (ko[(s_) & 3] ^ kx)); \
            x0 = *reinterpret_cast<const LAS bf16x8*>(ka); x1 = *reinterpret_cast<const LAS bf16x8*>(ka + 32 * 256); } \
        else { const LAS char* ka = lds + OFF_KP + KB * SHM_KP + ATT_KPSWZ(r32, ((((s_) - 8) & 3) * 16 + hi * 8) * 2); \
            x0 = *reinterpret_cast<const LAS bf16x8*>(ka); x1 = *reinterpret_cast<const LAS bf16x8*>(ka + 32 * 128); } } while (0)
    ATT_KRD(0, c0, c1);
#pragma unroll
    for (int s = 0; s < NS; ++s) {
        if (s + 1 < NS) ATT_KRD(s + 1, n0, n1);
        ATT_SBAR();
        const bf16x8 qq = s < 8 ? qr[s & 7] : qpe[(s - 8) & 3];
        p0 = __builtin_amdgcn_mfma_f32_32x32x16_bf16(c0, qq, p0, 0, 0, 0);
        p1 = __builtin_amdgcn_mfma_f32_32x32x16_bf16(c1, qq, p1, 0, 0, 0);
        ATT_SBAR();
        c0 = n0; c1 = n1;
    }
#undef ATT_KRD
}
template <int VB>
__device__ __forceinline__ void pv_tile(f32x16* o, int vb0, bf16x8 pa0, bf16x8 pa1, bf16x8 pa2, bf16x8 pa3) {
#define ATT_TRRD(dst, off) asm volatile("ds_read_b64_tr_b16 %0, %1 offset:%2" : "=&v"(dst) : "v"(vb0), "i"(off) : "memory")
    s16x4 L0[4], H0[4], L1[4], H1[4];
#define ATT_PV_RD(d0, L, H) do { constexpr int b_ = OFF_V + VB * SHM_V + v_rd_off(d0, 0, 0); \
        ATT_TRRD(L[0], b_); ATT_TRRD(H[0], b_ + 2048); ATT_TRRD(L[1], b_ + 4096); ATT_TRRD(H[1], b_ + 6144); ATT_TRRD(L[2], b_ + 8192); ATT_TRRD(H[2], b_ + 10240); ATT_TRRD(L[3], b_ + 12288); ATT_TRRD(H[3], b_ + 14336); } while (0)
#define ATT_PV_MM(d0, L, H) do { \
        o[d0] = __builtin_amdgcn_mfma_f32_32x32x16_bf16(pa0, (bf16x8){L[0][0], L[0][1], L[0][2], L[0][3], H[0][0], H[0][1], H[0][2], H[0][3]}, o[d0], 0, 0, 0);   \
        o[d0] = __builtin_amdgcn_mfma_f32_32x32x16_bf16(pa1, (bf16x8){L[1][0], L[1][1], L[1][2], L[1][3], H[1][0], H[1][1], H[1][2], H[1][3]}, o[d0], 0, 0, 0);   \
        o[d0] = __builtin_amdgcn_mfma_f32_32x32x16_bf16(pa2, (bf16x8){L[2][0], L[2][1], L[2][2], L[2][3], H[2][0], H[2][1], H[2][2], H[2][3]}, o[d0], 0, 0, 0);   \
        o[d0] = __builtin_amdgcn_mfma_f32_32x32x16_bf16(pa3, (bf16x8){L[3][0], L[3][1], L[3][2], L[3][3], H[3][0], H[3][1], H[3][2], H[3][3]}, o[d0], 0, 0, 0); } while (0)
    ATT_PV_RD(0, L0, H0);
    ATT_PV_RD(1, L1, H1); asm volatile("s_waitcnt lgkmcnt(8)" ::: "memory"); ATT_SBAR(); ATT_PV_MM(0, L0, H0); ATT_SBAR();
    ATT_PV_RD(2, L0, H0); asm volatile("s_waitcnt lgkmcnt(8)" ::: "memory"); ATT_SBAR(); ATT_PV_MM(1, L1, H1); ATT_SBAR();
    ATT_PV_RD(3, L1, H1); asm volatile("s_waitcnt lgkmcnt(8)" ::: "memory"); ATT_SBAR(); ATT_PV_MM(2, L0, H0); ATT_SBAR();
    asm volatile("s_waitcnt lgkmcnt(0)" ::: "memory"); ATT_SBAR(); ATT_PV_MM(3, L1, H1);
#undef ATT_PV_MM
#undef ATT_PV_RD
#undef ATT_TRRD
}
template <int TYPE>
__device__ __forceinline__ void softmax_tile(f32x16& p0, f32x16& p1, float& m_reg, float& l_reg, float& alpha, bf16x8& pa0, bf16x8& pa1, bf16x8& pa2, bf16x8& pa3,
                                             const LAS float* bias, int hi, bool need_mask, int lo, int dq) {
    constexpr float C2 = (TYPE == 0 ? 0.07216878364870322f : 0.08838834764831845f) * LOG2E;
    if (TYPE == 1) {
#pragma unroll
        for (int g = 0; g < 4; ++g) { const f32x4 b0 = *(const LAS f32x4*)(bias + 8 * g + 4 * hi), b1 = *(const LAS f32x4*)(bias + 32 + 8 * g + 4 * hi);
#pragma unroll
            for (int i = 0; i < 4; ++i) { p0[4 * g + i] = fmaf(p0[4 * g + i], C2, b0[i]); p1[4 * g + i] = fmaf(p1[4 * g + i], C2, b1[i]); } }
    } else {
#pragma unroll
        for (int r = 0; r < 16; ++r) { p0[r] *= C2; p1[r] *= C2; }
    }
    if (need_mask) {
        const float NEG = -__builtin_inff(); const int loh = lo - 4 * hi, dqh = dq - 4 * hi;
#pragma unroll
        for (int r = 0; r < 16; ++r) { const int c = (r & 3) + 8 * (r >> 2);
            if (c < loh || c > dqh) p0[r] = NEG;
            if (c + 32 < loh || c + 32 > dqh) p1[r] = NEG; }
    }
    float pmax = p0[0];
#pragma unroll
    for (int r = 1; r < 16; ++r) pmax = fmaxf(pmax, p0[r]);
#pragma unroll
    for (int r = 0; r < 16; ++r) pmax = fmaxf(pmax, p1[r]);
    { auto rr = __builtin_amdgcn_permlane32_swap(__float_as_uint(pmax), __float_as_uint(pmax), false, false);
      pmax = fmaxf(__uint_as_float(rr[0]), __uint_as_float(rr[1])); }
    float mn;
    if (__builtin_expect(__all(pmax - m_reg <= THR2), 1)) { mn = m_reg; alpha = 1.f; }
    else { mn = fmaxf(m_reg, pmax); alpha = __builtin_amdgcn_exp2f(m_reg - mn); m_reg = mn; }
#pragma unroll
    for (int r = 0; r < 16; ++r) { p0[r] = __builtin_amdgcn_exp2f(p0[r] - mn); p1[r] = __builtin_amdgcn_exp2f(p1[r] - mn); }
    float ps = 0.f;
#pragma unroll
    for (int r = 0; r < 16; ++r) ps += p0[r];
#pragma unroll
    for (int r = 0; r < 16; ++r) ps += p1[r];
    { auto rr = __builtin_amdgcn_permlane32_swap(__float_as_uint(ps), __float_as_uint(ps), false, false);
      ps = __uint_as_float(rr[0]) + __uint_as_float(rr[1]); }
    l_reg = l_reg * alpha + ps;
#define ATT_PK4(P, B_, OUT) do { unsigned a0 = cvtpk(P[B_+0], P[B_+1]), a1 = cvtpk(P[B_+2], P[B_+3]);                          \
        unsigned b0 = cvtpk(P[B_+4], P[B_+5]), b1 = cvtpk(P[B_+6], P[B_+7]);                                             \
        auto r0 = __builtin_amdgcn_permlane32_swap(a0, b0, false, false); auto r1 = __builtin_amdgcn_permlane32_swap(a1, b1, false, false); \
        u32x4 w = {r0[0], r1[0], r0[1], r1[1]}; OUT = *reinterpret_cast<bf16x8*>(&w); } while (0)
    ATT_PK4(p0, 0, pa0); ATT_PK4(p0, 8, pa1); ATT_PK4(p1, 0, pa2); ATT_PK4(p1, 8, pa3);
#undef ATT_PK4
}

template <int TYPE>
__device__ __forceinline__ void attn_block(const Args& a, LAS char* lds, int b, int h, int q0, int row_store_end, int tid, int lane, int wid) {
    const int r32 = lane & 31, hi = lane >> 5;
    const size_t rb = (size_t)b * LL;
    constexpr int QS = TYPE == 0 ? NQ : NPROJ, KS = TYPE == 0 ? NKV : NPROJ;
    const bf16_t* Qn = TYPE == 0 ? WSP(const bf16_t, WS_QM) + h * 128 : WSP(const bf16_t, WS_PROJ) + PC_FQ + h * 128;
    const bf16_t* Kn = TYPE == 0 ? WSP(const bf16_t, WS_KVM) + h * 128 : WSP(const bf16_t, WS_PROJ) + PC_FK + h * 128;
    const bf16_t* Vv = TYPE == 0 ? WSP(const bf16_t, WS_KVM) + 1536 + h * 128 : WSP(const bf16_t, WS_PROJ) + PC_FV + h * 128;
    const bf16_t* Kp = WSP(const bf16_t, WS_KPE);
    const float* cf = WSP(const float, WS_CF) + ((size_t)b * 12 + h) * LL;
    const int qrow = q0 + wid * 32 + r32, qlo = q0 + wid * 32;
    bf16x8 qr[8], qpe[4];
#pragma unroll
    for (int d0 = 0; d0 < 8; ++d0) qr[d0] = *(const bf16x8*)(Qn + (rb + qrow) * QS + d0 * 16 + hi * 8);
#pragma unroll
    for (int d0 = 0; d0 < 4; ++d0) qpe[d0] = TYPE == 0 ? *(const bf16x8*)(WSP(const bf16_t, WS_QM) + (rb + qrow) * NQ + 1536 + h * 64 + d0 * 16 + hi * 8) : qr[0];
    const int NT = (q0 + 256) / 64 - 1;
    const int sr = tid >> 4, sc = (tid & 15) * 8, kws = ATT_KSWZ(sr, sc * 2), vst0 = v_st(sr, sc), vst1 = v_st(32 + sr, sc);
    const int kpkey = tid >> 3, kpch = tid & 7, kpws = ATT_KPSWZ(kpkey, kpch * 16);
    const int vb0 = (int)(unsigned)(uintptr_t)(lds + OFF_V) + v_rd_base(lane);
    LAS float* wsl = (LAS float*)(lds + OFF_WS) + wid * 64; LAS float* li_l = wsl; LAS float* al_l = wsl + 32;
    LAS unsigned* votes = (LAS unsigned*)(lds + OFF_VOTE);
    bf16x8 sk0, sk1, sv0, sv1, skp; float sbias = 0.f;
    const unsigned koff = (unsigned)(sr * KS + sc) * 2u, kpoff = (unsigned)(kpkey * 64 + kpch * 8) * 2u, boff = (unsigned)(tid & 63) * 4u;
    float qn = 0.f;
    if (TYPE == 1) {
#pragma unroll
        for (int d0 = 0; d0 < 8; ++d0)
#pragma unroll
            for (int e = 0; e < 8; ++e) { const float x = bf2f((bf16_t)qr[d0][e]); qn += x * x; }
        { auto rr = __builtin_amdgcn_permlane32_swap(__float_as_uint(qn), __float_as_uint(qn), false, false); qn = __uint_as_float(rr[0]) + __uint_as_float(rr[1]); }
        qn = sqrtf(qn) * (0.08838834764831845f * LOG2E * 1.001f);
    }
    const float* kpm = WSP(const float, WS_KPM) + ((size_t)b * 12 + h) * (LL / 64);
#define ATT_LOADT(kb) do { const char* kt_ = (const char*)(Kn + (rb + (kb)) * KS); const char* vt_ = (const char*)(Vv + (rb + (kb)) * KS); \
        sk0 = *(const bf16x8*)(kt_ + koff); sk1 = *(const bf16x8*)(kt_ + (size_t)32 * KS * 2 + koff); \
        sv0 = *(const bf16x8*)(vt_ + koff); sv1 = *(const bf16x8*)(vt_ + (size_t)32 * KS * 2 + koff); \
        if (TYPE == 0) skp = *(const bf16x8*)((const char*)(Kp + (rb + (kb)) * 64) + kpoff); \
        if (TYPE == 1 && tid < 64) sbias = *(const float*)((const char*)(cf + (kb)) + boff); } while (0)
#define ATT_WRITET(bf) do { *(LAS bf16x8*)(lds + OFF_K + (bf) * SHM_K + kws) = sk0; *(LAS bf16x8*)(lds + OFF_K + (bf) * SHM_K + kws + 32 * 256) = sk1; \
        *(LAS bf16x8*)(lds + OFF_V + (bf) * SHM_V + vst0) = sv0; *(LAS bf16x8*)(lds + OFF_V + (bf) * SHM_V + vst1) = sv1; \
        if (TYPE == 0) *(LAS bf16x8*)(lds + OFF_KP + (bf) * SHM_KP + kpws) = skp; \
        if (TYPE == 1 && tid < 64) *(LAS float*)(lds + OFF_BIAS + (bf) * 256 + tid * 4) = -sbias * LOG2E; } while (0)
    float m_reg = -1e30f, l_reg = 0.f, alpha = 1.f; f32x16 o[4] = {};
    f32x16 p0, p1; bf16x8 pa0, pa1, pa2, pa3;
    bool stop = false;
    __syncthreads();
    ATT_LOADT(64 * NT); ATT_WRITET(0);
    __syncthreads();
#define ATT_STEP(t, BUF) do { const int kb_ = 64 * (NT - (t)); const bool more_ = (t) + 1 < NT; \
        if (more_) ATT_LOADT(kb_ - 64); \
        ATT_SBAR(); __builtin_amdgcn_s_setprio(1); qkt<BUF, TYPE>(p0, p1, lds, r32, hi, qr, qpe); __builtin_amdgcn_s_setprio(0); \
        softmax_tile<TYPE>(p0, p1, m_reg, l_reg, alpha, pa0, pa1, pa2, pa3, (const LAS float*)(lds + OFF_BIAS + (BUF) * 256), hi, kb_ == 64 || kb_ + 63 > qlo, NPAD - kb_, qrow - kb_); \
        if (TYPE == 1 && more_) { const float bnd_ = qn * kpm[kb_ / 64 - 1] - cf[kb_ - 1] * LOG2E; const bool ok_ = (bnd_ - m_reg < -170.f) || (qrow < NPAD); \
            const bool all_ = __all(ok_); if (lane == 0) votes[((t) & 1) * 8 + wid] = all_ ? 1u : 0u; } \
        if (__any(alpha < 1.f)) { if (hi == 0) al_l[r32] = alpha; asm volatile("s_waitcnt lgkmcnt(0)" ::: "memory"); \
            _Pragma("unroll") for (int d_ = 0; d_ < 4; ++d_) _Pragma("unroll") for (int r = 0; r < 16; ++r) o[d_][r] *= al_l[crow(r, hi)]; } \
        ATT_SBAR(); __builtin_amdgcn_s_setprio(1); pv_tile<BUF>(o, vb0, pa0, pa1, pa2, pa3); __builtin_amdgcn_s_setprio(0); \
        if (more_) ATT_WRITET((BUF) ^ 1); \
        __syncthreads(); \
        if (TYPE == 1 && more_) { const u32x4 va_ = *(const LAS u32x4*)(votes + ((t) & 1) * 8), vb_ = *(const LAS u32x4*)(votes + ((t) & 1) * 8 + 4); \
            stop = (va_[0] & va_[1] & va_[2] & va_[3] & vb_[0] & vb_[1] & vb_[2] & vb_[3]) != 0u; } } while (0)
#define ATT_SKIP(t, BUF) do { const int kb_ = 64 * (NT - (t)); const bool more_ = (t) + 1 < NT; \
        if (more_) ATT_LOADT(kb_ - 64); \
        if (TYPE == 1 && more_ && lane == 0) votes[((t) & 1) * 8 + wid] = 0u;        \
        if (more_) ATT_WRITET((BUF) ^ 1); \
        __syncthreads(); } while (0)
    int t = 0;
    { int ts = NT - (qlo + 31) / 64; ts = (ts < 0 ? 0 : ts > NT ? NT : ts) & ~1;
      for (; t < ts; t += 2) { ATT_SKIP(t, 0); ATT_SKIP(t + 1, 1); } }
#undef ATT_SKIP
    for (; t + 1 < NT && !stop; t += 2) { ATT_STEP(t, 0); if (!stop) ATT_STEP(t + 1, 1); }
    if (!stop && t < NT) ATT_STEP(t, 0);
    if (hi == 0) li_l[r32] = l_reg;
    asm volatile("s_waitcnt lgkmcnt(0)" ::: "memory");
    if (qlo < row_store_end) {
        int hoff = 4 * hi; asm volatile("" : "+v"(hoff));
        bf16_t* Ow = WSP(bf16_t, WS_MIX) + (rb + qlo) * DM + (TYPE == 0 ? 0 : 2560) + h * 128 + r32;
#pragma unroll
        for (int r = 0; r < 16; ++r) { const int orow = (r & 3) + 8 * (r >> 2) + hoff; const float lv = li_l[orow]; const float inv = lv > 0.f ? __builtin_amdgcn_rcpf(lv) : 0.f;
            const float x0 = o[0][r] * inv, x1 = o[1][r] * inv, x2 = o[2][r] * inv, x3 = o[3][r] * inv;
            float ss = (x0 * x0 + x1 * x1) + (x2 * x2 + x3 * x3);
            ss += __shfl_xor(ss, 1); ss += __shfl_xor(ss, 2); ss += __shfl_xor(ss, 4); ss += __shfl_xor(ss, 8); ss += __shfl_xor(ss, 16);
            const float rs = 1.0f / sqrtf(ss * (1.0f / 128.f) + EPS);
            bf16_t* op = Ow + (size_t)orow * DM;
            op[0] = f2bf(x0 * rs); op[32] = f2bf(x1 * rs); op[64] = f2bf(x2 * rs); op[96] = f2bf(x3 * rs); }
    }
#undef ATT_LOADT
#undef ATT_WRITET
#undef ATT_STEP
}
}
constexpr int ATT_SCHED_LEN = 4;
__device__ const unsigned short ATT_SCHED[256][4] = {
{15,696,65535,65535},
{32,713,65535,65535},
{49,730,65535,65535},
{66,747,65535,65535},
{83,764,65535,65535},
{100,781,65535,65535},
{117,798,65535,65535},
{134,815,65535,65535},
{151,65535,65535,65535},
{168,65535,65535,65535},
{185,65535,65535,65535},
{202,65535,65535,65535},
{219,65535,65535,65535},
{236,65535,65535,65535},
{253,65535,65535,65535},
{270,65535,65535,65535},
{287,65535,65535,65535},
{304,65535,65535,65535},
{321,65535,65535,65535},
{338,65535,65535,65535},
{355,65535,65535,65535},
{372,65535,65535,65535},
{389,65535,65535,65535},
{406,65535,65535,65535},
{14,272,65535,65535},
{31,289,65535,65535},
{48,306,65535,65535},
{65,323,65535,65535},
{82,340,65535,65535},
{99,357,65535,65535},
{116,374,65535,65535},
{133,391,65535,65535},
{150,408,65535,65535},
{167,425,65535,65535},
{184,442,65535,65535},
{201,459,65535,65535},
{218,476,65535,65535},
{235,493,65535,65535},
{252,510,65535,65535},
{269,527,65535,65535},
{286,544,65535,65535},
{303,561,65535,65535},
{320,578,65535,65535},
{337,595,65535,65535},
{354,612,65535,65535},
{371,629,65535,65535},
{388,646,65535,65535},
{405,663,65535,65535},
{13,682,65535,65535},
{30,699,65535,65535},
{47,716,65535,65535},
{64,733,65535,65535},
{81,750,65535,65535},
{98,767,65535,65535},
{115,784,65535,65535},
{132,801,65535,65535},
{149,683,65535,65535},
{166,700,65535,65535},
{183,717,65535,65535},
{200,734,65535,65535},
{217,751,65535,65535},
{234,768,65535,65535},
{251,785,65535,65535},
{268,802,65535,65535},
{285,684,65535,65535},
{302,701,65535,65535},
{319,718,65535,65535},
{336,735,65535,65535},
{353,752,65535,65535},
{370,769,65535,65535},
{387,786,65535,65535},
{404,803,65535,65535},
{12,551,680,65535},
{29,568,697,65535},
{46,585,714,65535},
{63,602,731,65535},
{80,619,748,65535},
{97,636,765,65535},
{114,653,782,65535},
{131,670,799,65535},
{148,552,16,65535},
{165,569,33,65535},
{182,586,50,65535},
{199,603,67,65535},
{216,620,84,65535},
{233,637,101,65535},
{250,654,118,65535},
{267,671,135,65535},
{284,553,152,65535},
{301,570,169,65535},
{318,587,186,65535},
{335,604,203,65535},
{352,621,220,65535},
{369,638,237,65535},
{386,655,254,65535},
{403,672,271,65535},
{11,417,685,65535},
{28,434,702,65535},
{45,451,719,65535},
{62,468,736,65535},
{79,485,753,65535},
{96,502,770,65535},
{113,519,787,65535},
{130,536,804,65535},
{147,418,686,65535},
{164,435,703,65535},
{181,452,720,65535},
{198,469,737,65535},
{215,486,754,65535},
{232,503,771,65535},
{249,520,788,65535},
{266,537,805,65535},
{283,419,687,65535},
{300,436,704,65535},
{317,453,721,65535},
{334,470,738,65535},
{351,487,755,65535},
{368,504,772,65535},
{385,521,789,65535},
{402,538,806,65535},
{10,410,554,288},
{27,427,571,305},
{44,444,588,322},
{61,461,605,339},
{78,478,622,356},
{95,495,639,373},
{112,512,656,390},
{129,529,673,407},
{146,411,555,424},
{163,428,572,441},
{180,445,589,458},
{197,462,606,475},
{214,479,623,492},
{231,496,640,509},
{248,513,657,526},
{265,530,674,543},
{282,412,556,560},
{299,429,573,577},
{316,446,590,594},
{333,463,607,611},
{350,480,624,628},
{367,497,641,645},
{384,514,658,662},
{401,531,675,679},
{9,137,421,689},
{26,154,438,706},
{43,171,455,723},
{60,188,472,740},
{77,205,489,757},
{94,222,506,774},
{111,239,523,791},
{128,256,540,808},
{145,273,422,690},
{162,290,439,707},
{179,307,456,724},
{196,324,473,741},
{213,341,490,758},
{230,358,507,775},
{247,375,524,792},
{264,392,541,809},
{281,409,420,688},
{298,426,437,705},
{315,443,454,722},
{332,460,471,739},
{349,477,488,756},
{366,494,505,773},
{383,511,522,790},
{400,528,539,807},
{8,138,423,691},
{25,155,440,708},
{42,172,457,725},
{59,189,474,742},
{76,206,491,759},
{93,223,508,776},
{110,240,525,793},
{127,257,542,810},
{144,274,545,692},
{161,291,562,709},
{178,308,579,726},
{195,325,596,743},
{212,342,613,760},
{229,359,630,777},
{246,376,647,794},
{263,393,664,811},
{280,1,413,557},
{297,18,430,574},
{314,35,447,591},
{331,52,464,608},
{348,69,481,625},
{365,86,498,642},
{382,103,515,659},
{399,120,532,676},
{7,139,546,693},
{24,156,563,710},
{41,173,580,727},
{58,190,597,744},
{75,207,614,761},
{92,224,631,778},
{109,241,648,795},
{126,258,665,812},
{143,275,547,694},
{160,292,564,711},
{177,309,581,728},
{194,326,598,745},
{211,343,615,762},
{228,360,632,779},
{245,377,649,796},
{262,394,666,813},
{279,2,414,558},
{296,19,431,575},
{313,36,448,592},
{330,53,465,609},
{347,70,482,626},
{364,87,499,643},
{381,104,516,660},
{398,121,533,677},
{6,140,548,695},
{23,157,565,712},
{40,174,582,729},
{57,191,599,746},
{74,208,616,763},
{91,225,633,780},
{108,242,650,797},
{125,259,667,814},
{142,276,549,0},
{159,293,566,17},
{176,310,583,34},
{193,327,600,51},
{210,344,617,68},
{227,361,634,85},
{244,378,651,102},
{261,395,668,119},
{278,3,415,559},
{295,20,432,576},
{312,37,449,593},
{329,54,466,610},
{346,71,483,627},
{363,88,500,644},
{380,105,517,661},
{397,122,534,678},
{5,277,550,136},
{22,294,567,153},
{39,311,584,170},
{56,328,601,187},
{73,345,618,204},
{90,362,635,221},
{107,379,652,238},
{124,396,669,255},
{141,4,416,681},
{158,21,433,698},
{175,38,450,715},
{192,55,467,732},
{209,72,484,749},
{226,89,501,766},
{243,106,518,783},
{260,123,535,800}
};
constexpr int ATT_UNITS2 = 2 * 2 * 12 * 17;
__device__ __forceinline__ void att_unit(const Args& a, LAS char* lds, int uid, int tid, int lane, int wid) {
    const int blk = uid % 17, rest = uid / 17, h = rest % 12, tb = rest / 12, b = tb & 1, ty = tb >> 1;
    const int q0 = blk == 16 ? 0 : 128 + 256 * blk, rse = blk == 16 ? 128 : (1 << 30);
    if (ty == 0) att::attn_block<0>(a, lds, b, h, q0, rse, tid, lane, wid); else att::attn_block<1>(a, lds, b, h, q0, rse, tid, lane, wid);
}
__device__ __forceinline__ void phase_attn2(const Args& a, LAS unsigned char* lds_, int tid, int lane, int wid) {
    LAS char* lds = (LAS char*)lds_;
    const bool tab = gridDim.x == 256;
    for (int k = 0; ; ++k) {
        int uid;
        if (tab) { if (k >= ATT_SCHED_LEN) break; uid = ATT_SCHED[blockIdx.x][k]; if (uid == 0xFFFF) break; }
        else { uid = blockIdx.x + k * gridDim.x; if (uid >= ATT_UNITS2) break; }
        att_unit(a, lds, uid, tid, lane, wid);
    }
}

__device__ __forceinline__ void phase_mixnorm(const Args& a, int gw, int NGW, int lane) {
    for (int row = gw; row < R; row += NGW) {
        const f32x4* src = (const f32x4*)(WSP(float, WS_OG) + (size_t)row * DM); u32x2* dst = (u32x2*)(WSP(bf16_t, WS_MIX) + (size_t)row * DM);
#pragma unroll
        for (int j = 0; j < 16; ++j) {
            f32x4 v = src[64 * j + lane];
            float ss = (v.x * v.x + v.y * v.y) + (v.z * v.z + v.w * v.w);
            ss += __shfl_xor(ss, 1); ss += __shfl_xor(ss, 2); ss += __shfl_xor(ss, 4); ss += __shfl_xor(ss, 8); ss += __shfl_xor(ss, 16);
            float rs;
            if (j >= 6 && j < 10) { ss += __shfl_xor(ss, 32); rs = 1.0f / sqrtf(ss * (1.0f / 256.f) + EPS);
                const u32x2 g = *(const u32x2*)(WSP(bf16_t, WS_PROJ) + (size_t)row * NPROJ + PC_GR + (j - 6) * 256 + 4 * lane);
                const float g0 = __uint_as_float(g.x << 16), g1 = __uint_as_float(g.x & 0xffff0000u), g2 = __uint_as_float(g.y << 16), g3 = __uint_as_float(g.y & 0xffff0000u);
                v.x *= rs * (g0 / (1.0f + __expf(-g0))); v.y *= rs * (g1 / (1.0f + __expf(-g1))); v.z *= rs * (g2 / (1.0f + __expf(-g2))); v.w *= rs * (g3 / (1.0f + __expf(-g3)));
            } else { rs = 1.0f / sqrtf(ss * (1.0f / 128.f) + EPS); v = v * rs; }
            u32x2 w; w.x = pk2(v.x, v.y); w.y = pk2(v.z, v.w); dst[64 * j + lane] = w;
        }
    }
}

__device__ __forceinline__ void phase_convfix(const Args& a, int layer, int tid) {
    const float* cw = a.in[17] + (size_t)layer * 3 * NUP; const float* cb = a.in[18] + (size_t)layer * NUP;
    const float* UM = WSP(const float, WS_UM); const float* EDGE = WSP(const float, WS_EDGE);
    constexpr int NCH = DFF / 8, NROWS = 16 + 64;
    for (int item = blockIdx.x * 512 + tid; item < NROWS * NCH; item += gridDim.x * 512) {
        const int rr = item / NCH, chk = item - rr * NCH, ch0 = chk * 8, gcol = (ch0 >> 7) * 256 + (ch0 & 127);
        const float* X; const float* P1; const float* P2; int orow0, orow1;
        if (rr < 16) { X = UM + (size_t)rr * NUP; P1 = rr >= 1 ? UM + (size_t)(rr - 1) * NUP : nullptr; P2 = rr >= 2 ? UM + (size_t)(rr - 2) * NUP : nullptr; orow0 = NPAD + rr; orow1 = LL + NPAD + rr; }
        else { const int k = rr - 16, pm = k >> 1, j = k & 1; const bool i0 = (pm & 15) == 0; const float* E = EDGE + (size_t)pm * 4 * NUP;
            const float* prev3 = i0 ? UM + (size_t)15 * NUP : E - (size_t)1 * NUP; const float* prev2 = i0 ? UM + (size_t)14 * NUP : E - (size_t)2 * NUP;
            if (j == 0) { X = E; P1 = prev3; P2 = prev2; } else { X = E + NUP; P1 = E; P2 = prev3; }
            orow0 = pg8::prow(pm) + j; orow1 = -1; }
        float o[8];
#pragma unroll
        for (int h = 0; h < 2; ++h) {
            const int cg_ = gcol + 4 * h, ch = ch0 + 4 * h;
            const f32x4 xg = *(const f32x4*)(X + cg_), xv = *(const f32x4*)(X + cg_ + 128);
            const f32x4 z = {0.f, 0.f, 0.f, 0.f};
            const f32x4 p1g = P1 ? *(const f32x4*)(P1 + cg_) : z, p1v = P1 ? *(const f32x4*)(P1 + cg_ + 128) : z, p2g = P2 ? *(const f32x4*)(P2 + cg_) : z, p2v = P2 ? *(const f32x4*)(P2 + cg_ + 128) : z;
            const f32x4 wg0 = *(const f32x4*)(cw + ch), wg1 = *(const f32x4*)(cw + NUP + ch), wg2 = *(const f32x4*)(cw + 2 * NUP + ch), bg = *(const f32x4*)(cb + ch);
            const f32x4 wv0 = *(const f32x4*)(cw + DFF + ch), wv1 = *(const f32x4*)(cw + NUP + DFF + ch), wv2 = *(const f32x4*)(cw + 2 * NUP + DFF + ch), bv = *(const f32x4*)(cb + DFF + ch);
#pragma unroll
            for (int e = 0; e < 4; ++e) { const float cg = bg[e] + wg0[e] * p2g[e] + wg1[e] * p1g[e] + wg2[e] * xg[e], cv = bv[e] + wv0[e] * p2v[e] + wv1[e] * p1v[e] + wv2[e] * xv[e];
                o[4 * h + e] = cg * __builtin_amdgcn_rcpf(1.0f + __expf(-cg)) * cv; }
        }
        u32x4 w; w.x = pk2(o[0], o[1]); w.y = pk2(o[2], o[3]); w.z = pk2(o[4], o[5]); w.w = pk2(o[6], o[7]);
        *(u32x4*)(WSP(bf16_t, WS_ACT) + (size_t)orow0 * DFF + ch0) = w;
        if (orow1 >= 0) *(u32x4*)(WSP(bf16_t, WS_ACT) + (size_t)orow1 * DFF + ch0) = w;
    }
}

constexpr int NPH_LAYER = 12, NPHASES = 1 + 2 * NPH_LAYER;
#define IN(k) (lo <= (k) && (k) < hi)
#define SEAM(k) do { if (IN(k) && IN((k) + 1)) xcd_barrier(bar); } while (0)
#define SEAM2(k, kn) do { if (IN(k) && IN(kn)) xcd_barrier(bar); } while (0)
#define TIDX() int lane_x; asm volatile("v_mbcnt_lo_u32_b32 %0, -1, 0\n\tv_mbcnt_hi_u32_b32 %0, -1, %0" : "=v"(lane_x)); const int lane = lane_x, wave = wave_s, tid = wave * 64 + lane; const int gw = blockIdx.x * 8 + wave, NGW = gridDim.x * 8; (void)gw; (void)NGW; (void)lane
template <int LAYER>
__device__ __forceinline__ void layer_phases(const Args& a, const XcdBarrier& bar, LAS unsigned char* lds, int lo, int hi, const int wave_s) {
    constexpr int pb = 1 + NPH_LAYER * LAYER;
    constexpr size_t WB = WS_W + (size_t)LAYER * SZ_WLAYER;
    if (IN(pb + 0)) {
        pg8::Gemm g{WSP(bf16_t, WS_H), WSP(const bf16_t, WB + OFF_WIN), R, NIN, DM};   pg8::StaticOrder S; S.init(NB * SEQ, NIN, (int)gridDim.x, (int)blockIdx.x);
        pg8::EpiBf E{WSP(bf16_t, WS_PROJ), NPROJ, 38, 1 << 30, WSP(float, WS_SMALL), NSM, WSP(float, WS_CS), (const unsigned long long*)(a.ws + (LAYER == 0 ? WS_SS0 : WS_SS1))};
        pg8::gemm_phase<pg8::EpiBf, pg8::StaticOrder, true, true>(lds, g, S, E, wave_s);
        __syncthreads();
        { TIDX(); (void)tid; const SkEmit e{0, WSP(bf16_t, WS_PROJ), NPROJ, NPROJ, WSP(float, WS_SMALL), NSM, 1 << 30, WSP(float, WS_CS), nullptr, (const unsigned long long*)(a.ws + (LAYER == 0 ? WS_SS0 : WS_SS1)), nullptr};
          skinny_gemm(g.A, g.Bt, NIN, DM, 32 * (NIN / 256), e, lds, lane, wave); }
    }
    SEAM(pb + 0);
    if (IN(pb + 1)) { TIDX(); phase_prep_rows(a, LAYER, gw, NGW, lane); }
    SEAM(pb + 1);
    if (IN(pb + 2)) {
        { pg8::Gemm g{WSP(bf16_t, WS_CQN), WSP(const bf16_t, WB + OFF_WUQ), R, NQ, 1536}; pg8::StaticOrder S; S.init(NB * SEQ, NQ, (int)gridDim.x, (int)blockIdx.x);
          pg8::EpiBf E{WSP(bf16_t, WS_QM), NQ, 1 << 30, 6, nullptr, 0, WSP(float, WS_CS), nullptr};
          pg8::gemm_phase<pg8::EpiBf, pg8::StaticOrder, true, true>(lds, g, S, E, wave_s);
          __syncthreads();
          TIDX(); (void)tid; const SkEmit e{0, WSP(bf16_t, WS_QM), NQ, 1 << 30, nullptr, 0, 1536, WSP(float, WS_CS), nullptr, nullptr, nullptr};
          skinny_gemm(g.A, g.Bt, NQ, 1536, 32 * (NQ / 256), e, lds, lane, wave); }
        __syncthreads();
        { pg8::Gemm g{WSP(bf16_t, WS_CKVN), WSP(const bf16_t, WB + OFF_WUKV), R, NKV, 512}; pg8::StaticOrder S; S.init(NB * SEQ, NKV, (int)gridDim.x, (int)((blockIdx.x + gridDim.x / 2) % gridDim.x));
          pg8::EpiBf E{WSP(bf16_t, WS_KVM), NKV, 1 << 30, 1 << 30, nullptr, 0, WSP(float, WS_CS), nullptr};
          pg8::gemm_phase<pg8::EpiBf, pg8::StaticOrder, true, true>(lds, g, S, E, wave_s);
          __syncthreads();
          TIDX(); (void)tid; const SkEmit e{0, WSP(bf16_t, WS_KVM), NKV, 1 << 30, nullptr, 0, 1 << 30, WSP(float, WS_CS), nullptr, nullptr, nullptr};
          skinny_gemm(g.A, g.Bt, NKV, 512, 32 * (NKV / 256), e, lds, lane, wave); }
        __syncthreads();
        { TIDX(); phase_fcum(a, gw, lane); phase_gla_b1(a, lds, tid, lane, wave); }
    }
    SEAM(pb + 2);
    if (IN(pb + 3)) { TIDX(); phase_gla_b2(a, tid); }
    SEAM(pb + 3);
    if (IN(pb + 4)) { TIDX(); phase_attn2(a, lds, tid, lane, wave); __syncthreads(); phase_gla_b3(a, lds, tid, lane, wave); }
    SEAM2(pb + 4, pb + 6);
    if (IN(pb + 6)) {
        pg8::Gemm g{WSP(bf16_t, WS_MIX), WSP(const bf16_t, WB + OFF_WOUT), R, DM, DM}; pg8::StaticOrder S; S.init(NB * SEQ, DM, (int)gridDim.x, (int)blockIdx.x);
        pg8::EpiRes<false> E{WSP(bf16_t, WS_H), DM, nullptr};
        pg8::gemm_phase<pg8::EpiRes<false>, pg8::StaticOrder, true, true>(lds, g, S, E, wave_s);
        __syncthreads();
        { TIDX(); (void)tid; unsigned long long* const SSQ_ = nullptr; const SkEmit e{2, nullptr, 0, 0, nullptr, 0, 1 << 30, nullptr, WSP(bf16_t, WS_H), nullptr, SSQ_};
          skinny_gemm(g.A, g.Bt, DM, DM, 32 * (DM / 256), e, lds, lane, wave); }
    }
    SEAM(pb + 6);
    if (IN(pb + 7)) { TIDX(); norm_rows<3>(a, nullptr, gw, NGW, lane); }
    SEAM(pb + 7);
    if (IN(pb + 8)) {
        pg8::Gemm g{WSP(bf16_t, WS_HN), WSP(const bf16_t, WB + OFF_WUP), R, NUP, DM}; pg8::StaticOrder S; S.init(NB * SEQ, NUP, (int)gridDim.x, (int)blockIdx.x);
        pg8::Gemm gq{(const bf16_t*)(a.ws + WS_HNQ), (const bf16_t*)(a.ws + WS_WQ + (size_t)LAYER * SZ_WQ), R, NUP, DM / 2};
        pg8::EpiConv<true> E{WSP(bf16_t, WS_ACT), WSP(float, WS_EDGE), a.in[17] + (size_t)LAYER * 3 * NUP, a.in[18] + (size_t)LAYER * NUP, (LAS float*)(lds + MISC_OFF + 1024), WSP(const float, WS_ASC), WSP(const float, WS_WSC) + (size_t)LAYER * NUP};
        pg8::gemm_phase<pg8::EpiConv<true>, pg8::StaticOrder, true, true, true>(lds, gq, S, E, wave_s);
        __syncthreads();
        { TIDX(); (void)tid; const SkEmit e{3, nullptr, 0, 0, WSP(float, WS_UM), NUP, 1 << 30, nullptr, nullptr, nullptr, nullptr};
          skinny_gemm_i8(a.ws + WS_HNQ, a.ws + WS_WQ + (size_t)LAYER * SZ_WQ, NUP, 32 * (NUP / 256), WSP(const float, WS_ASC), WSP(const float, WS_WSC) + (size_t)LAYER * NUP, e, lds, lane, wave); (void)g; }
    }
    SEAM(pb + 8);
    if (IN(pb + 9)) { TIDX(); phase_convfix(a, LAYER, tid); }
    SEAM(pb + 9);
    if (IN(pb + 10)) {
        pg8::Gemm g{WSP(bf16_t, WS_ACT), WSP(const bf16_t, WB + OFF_WDN), R, DM, DFF}; pg8::StaticOrder S; S.init(NB * SEQ, DM, (int)gridDim.x, (int)blockIdx.x);
        unsigned long long* const SSQ_ = LAYER == 0 ? (unsigned long long*)(a.ws + WS_SS1) : nullptr;
        pg8::EpiRes<LAYER == 0> E{WSP(bf16_t, WS_H), DM, SSQ_};
        pg8::gemm_phase<pg8::EpiRes<LAYER == 0>, pg8::StaticOrder, true, true>(lds, g, S, E, wave_s);
        __syncthreads();
        { TIDX(); (void)tid; const SkEmit e{2, nullptr, 0, 0, nullptr, 0, 1 << 30, nullptr, WSP(bf16_t, WS_H), nullptr, SSQ_};
          skinny_gemm(g.A, g.Bt, DM, DFF, 32 * (DM / 256), e, lds, lane, wave); }
    }
    if (LAYER == 0) { SEAM2(pb + 10, pb + 12); }
    else { SEAM(pb + 10); if (IN(pb + 11)) { TIDX(); norm_rows<2>(a, a.in[20], gw, NGW, lane); } }
}
__global__ void __launch_bounds__(512, 2) fwd(Args a) {
    extern __shared__ __attribute__((aligned(16))) unsigned char lds_raw[];
    LAS unsigned char* lds = (LAS unsigned char*)lds_raw;
    const int lo = a.ph_lo, hi = a.ph_hi; const int wave_s = __builtin_amdgcn_readfirstlane(threadIdx.x >> 6);
    volatile LAS unsigned* MISC = (volatile LAS unsigned*)(lds + MISC_OFF);
    if (threadIdx.x < 64) MISC[threadIdx.x] = 0u;
    __syncthreads();
    XcdBarrier bar; bar.bar = (unsigned*)(a.ws + WS_CTL) + CW_BAR; bar.x = 0; bar.st = MISC + 8; bar.w0 = wave_s == 0 ? 1u : 0u;
    if (hi - lo > 1) { bar = xcd_barrier_post((unsigned*)(a.ws + WS_CTL) + CW_BAR, MISC + 8); bar.w0 = wave_s == 0 ? 1u : 0u; }
    if (IN(0)) { { TIDX(); for (int s = blockIdx.x; s < 2 * (NUP / 32); s += gridDim.x) prep_wup_strip(a, lds, s, tid, wave_s); __syncthreads(); }
                 { TIDX(); phase_prologue(a, lds, tid, lane, wave); } }
    SEAM(0);
    layer_phases<0>(a, bar, lds, lo, hi, wave_s);
    layer_phases<1>(a, bar, lds, lo, hi, wave_s);
}
#undef IN
#undef SEAM

#ifndef N_LAUNCH_MODE
#define N_LAUNCH_MODE 1
#endif
extern "C" void kernel_launch(void* const* d_in, const int* in_sizes, int n_in, void* d_out, int out_size, void* d_ws, size_t ws_size, hipStream_t stream) {
    static int grid = 0;
    if (grid == 0) {
        if (n_in != 21 || out_size != NB * SEQ * DM || ws_size < WS_END) { fprintf(stderr, "kernel_launch: unexpected shapes (n_in %d, out %d, ws %zu, need %zu)\n", n_in, out_size, ws_size, (size_t)WS_END); grid = -1; return; }
        int dev = 0, cus = 0;
        if (hipGetDevice(&dev) != hipSuccess || hipDeviceGetAttribute(&cus, hipDeviceAttributeMultiprocessorCount, dev) != hipSuccess || cus <= 0) { grid = -1; return; }
        if (hipFuncSetAttribute((const void*)fwd, hipFuncAttributeMaxDynamicSharedMemorySize, LDS_BYTES) != hipSuccess) { fprintf(stderr, "kernel_launch: hipFuncSetAttribute failed\n"); grid = -1; return; }
        int per_cu = 0;
        if (hipOccupancyMaxActiveBlocksPerMultiprocessor(&per_cu, (const void*)fwd, 512, LDS_BYTES) != hipSuccess || per_cu < 1) fprintf(stderr, "kernel_launch: occupancy query reports %d\n", per_cu);
        (void)hipGetLastError();
        grid = cus;
    }
    if (grid < 0) return;
    (void)hipMemsetAsync((char*)d_ws + WS_CTL, 0, CTL_ZERO_BYTES, stream);
    Args a{};
    for (int i = 0; i < 21; ++i) a.in[i] = (const float*)d_in[i];
    a.out = (float*)d_out; a.ws = (unsigned char*)d_ws;
#if N_LAUNCH_MODE == 1
    a.ph_lo = 0; a.ph_hi = NPHASES;
    hipLaunchKernelGGL(fwd, dim3(grid), dim3(512), LDS_BYTES, stream, a);
#else
    for (int ph = 0; ph < NPHASES; ++ph) { a.ph_lo = ph; a.ph_hi = ph + 1; hipLaunchKernelGGL(fwd, dim3(grid), dim3(512), LDS_BYTES, stream, a); }
#endif
}
```

```cpp
#include <hip/hip_runtime.h>
#include <cstdio>
#include <cstdint>
namespace pg8 {
#define PG8_LAS __attribute__((address_space(3)))
typedef unsigned short bf16_t;
typedef short bf16x8 __attribute__((ext_vector_type(8)));
typedef float f32x4 __attribute__((ext_vector_type(4)));
typedef unsigned u32x4 __attribute__((ext_vector_type(4)));
constexpr int BM = 256, BK = 64, HALF = 128, HTB = HALF * BK * 2  , STAGE_BYTES = 8 * HTB, NXCD = 8, WGM = 8;

__host__ __device__ __forceinline__ int lds_byte(int r, int c) { const int st = (r >> 4) * 2 + (c >> 5), rr = r & 15, cc = c & 31, ob = rr * 64 + cc * 2; return st * 1024 + (ob ^ (((ob >> 9) & 1) << 5)); }
__host__ __device__ __forceinline__ void stage_rc(int b, int& R, int& C) { const int st = b / 1024, sb = b % 1024, swz = sb ^ (((sb >> 9) & 1) << 5); R = (st >> 1) * 16 + swz / 64; C = (st & 1) * 32 + (swz % 64) / 2; }
__host__ __device__ __forceinline__ int perm32(int rho) { const int n = rho >> 4, i = rho & 15; return 8 * (i >> 2) + 4 * n + (i & 3); }

struct Unit { int pm, pn; };
__host__ __device__ __forceinline__ int prow(int pm) { return (pm >> 4) * 4224 + 128 + (pm & 15) * 256; }
struct Gemm { const bf16_t* A; const bf16_t* Bt; int M, N, K; };

struct StaticOrder {
    int nM, nN, nwg, G, c;
    __host__ __device__ void init(int M, int N, int G_, int c_) { nM = M / BM; nN = N / BM; nwg = nM * nN; G = G_; c = c_; }
    __host__ __device__ bool next(int i, Unit& u) const {
        const long L = (long)i * G + c; if (L >= nwg) return false;
        int wgid = (int)L; { const int q = nwg / NXCD, r = nwg % NXCD, xcd = wgid % NXCD, off = wgid / NXCD; wgid = (xcd < r ? xcd * (q + 1) : r * (q + 1) + (xcd - r) * q) + off; }
        const int nig = WGM * nN, gid = wgid / nig, fm = gid * WGM, gsz = (nM - fm) < WGM ? (nM - fm) : WGM;
        u.pm = fm + ((wgid % nig) % gsz); u.pn = (wgid % nig) / gsz; return true;
    }
    __device__ __forceinline__ void a_ready(const Unit&) const {}
    __device__ __forceinline__ void done(const Unit&) const {}
};
typedef int i32x4 __attribute__((ext_vector_type(4)));
template <bool I8> struct AccSel { typedef f32x4 type; };
template <> struct AccSel<true> { typedef i32x4 type; };
__device__ __forceinline__ unsigned cvt_pk_bf16(float lo, float hi) { unsigned r; asm volatile("v_cvt_pk_bf16_f32 %0, %1, %2" : "=v"(r) : "v"(lo), "v"(hi)); return r; }
constexpr int EPI_LROWS = 4224, EPI_NPAD = 112;
struct EpiBf {
    static constexpr bool PERM = true, AFTER_DRAIN = false, APERM = false;
    bf16_t* O; int ldc; int nbf; int rope_from; float* F; int ldf; const float* cs; const unsigned long long* ssq;
    __device__ __forceinline__ void operator()(const f32x4 (&acc)[2][2][4][2], const Unit& u, int wr, int wc, int fr, int fq) const {
        const int row0 = prow(u.pm) + wr * 64 + fr, col0 = u.pn * BM + wc * 32 + 8 * fq;
        float rsc[2][4];
        if (ssq) { unsigned long long q[2][4];
#pragma unroll
            for (int ai = 0; ai < 2; ++ai)
#pragma unroll
                for (int m = 0; m < 4; ++m) q[ai][m] = ssq[row0 + ai * HALF + m * 16];
#pragma unroll
            for (int ai = 0; ai < 2; ++ai)
#pragma unroll
                for (int m = 0; m < 4; ++m) rsc[ai][m] = 1.0f / sqrtf((float)q[ai][m] * (1.0f / 4294967296.0f / 4096.0f) + 1e-6f);
        } else {
#pragma unroll
            for (int ai = 0; ai < 2; ++ai)
#pragma unroll
                for (int m = 0; m < 4; ++m) rsc[ai][m] = 1.0f;
        }
        if (u.pn < nbf) {
            const bool rope = u.pn >= rope_from;
#pragma unroll
            for (int ai = 0; ai < 2; ++ai)
#pragma unroll
                for (int m = 0; m < 4; ++m) { const int row = row0 + ai * HALF + m * 16; bf16_t* rowp = O + (size_t)row * ldc + col0;
#pragma unroll
                    for (int bj = 0; bj < 2; ++bj) { f32x4 v0 = acc[ai][bj][m][0] * rsc[ai][m], v1 = acc[ai][bj][m][1] * rsc[ai][m];
                        if (rope) { const int p = row % EPI_LROWS, i0 = ((col0 + bj * HALF) & 63) >> 1; const float* t = cs + ((size_t)p * 32 + i0) * 2;
                            const f32x4 t0 = *(const f32x4*)t, t1 = *(const f32x4*)(t + 4);
                            const f32x4 a = v0, b = v1;
                            v0[0] = a[0] * t0[0] - a[1] * t0[1]; v0[1] = a[1] * t0[0] + a[0] * t0[1]; v0[2] = a[2] * t0[2] - a[3] * t0[3]; v0[3] = a[3] * t0[2] + a[2] * t0[3];
                            v1[0] = b[0] * t1[0] - b[1] * t1[1]; v1[1] = b[1] * t1[0] + b[0] * t1[1]; v1[2] = b[2] * t1[2] - b[3] * t1[3]; v1[3] = b[3] * t1[2] + b[2] * t1[3]; }
                        u32x4 w; w.x = cvt_pk_bf16(v0[0], v0[1]); w.y = cvt_pk_bf16(v0[2], v0[3]); w.z = cvt_pk_bf16(v1[0], v1[1]); w.w = cvt_pk_bf16(v1[2], v1[3]);
                        *(u32x4*)(rowp + bj * HALF) = w; } }
        } else {
            const int fc0 = col0 - nbf * BM;
#pragma unroll
            for (int ai = 0; ai < 2; ++ai)
#pragma unroll
                for (int m = 0; m < 4; ++m) { const int row = row0 + ai * HALF + m * 16; float* rowp = F + (size_t)row * ldf + fc0;
#pragma unroll
                    for (int bj = 0; bj < 2; ++bj) { *(f32x4*)(rowp + bj * HALF) = acc[ai][bj][m][0] * rsc[ai][m]; *(f32x4*)(rowp + bj * HALF + 4) = acc[ai][bj][m][1] * rsc[ai][m]; } }
        }
    }
};
template <bool SSQ> struct EpiRes {
    static constexpr bool PERM = true, AFTER_DRAIN = false, APERM = false;
    bf16_t* H; int ldc; unsigned long long* ssq;
    __device__ __forceinline__ void operator()(const f32x4 (&acc)[2][2][4][2], const Unit& u, int wr, int wc, int fr, int fq) const {
        char* hb = (char*)(H + (size_t)prow(u.pm) * ldc + u.pn * BM);
        const unsigned lo = (unsigned)((wr * 64 + fr) * ldc + wc * 32 + 8 * fq) * 2u;
        u32x4 r[2][4][2];
#pragma unroll
        for (int ai = 0; ai < 2; ++ai)
#pragma unroll
            for (int m = 0; m < 4; ++m)
#pragma unroll
                for (int bj = 0; bj < 2; ++bj) r[ai][m][bj] = *(const u32x4*)(hb + lo + (unsigned)((ai * HALF + m * 16) * ldc + bj * HALF) * 2u);
#pragma unroll
        for (int ai = 0; ai < 2; ++ai)
#pragma unroll
            for (int m = 0; m < 4; ++m)
#pragma unroll
                for (int bj = 0; bj < 2; ++bj) { const u32x4 q = r[ai][m][bj]; const f32x4 v0 = acc[ai][bj][m][0], v1 = acc[ai][bj][m][1]; u32x4 w;
                    w.x = cvt_pk_bf16(v0[0] + __uint_as_float(q.x << 16), v0[1] + __uint_as_float(q.x & 0xffff0000u));
                    w.y = cvt_pk_bf16(v0[2] + __uint_as_float(q.y << 16), v0[3] + __uint_as_float(q.y & 0xffff0000u));
                    w.z = cvt_pk_bf16(v1[0] + __uint_as_float(q.z << 16), v1[1] + __uint_as_float(q.z & 0xffff0000u));
                    w.w = cvt_pk_bf16(v1[2] + __uint_as_float(q.w << 16), v1[3] + __uint_as_float(q.w & 0xffff0000u));
                    *(u32x4*)(hb + lo + (unsigned)((ai * HALF + m * 16) * ldc + bj * HALF) * 2u) = w;
                    if constexpr (SSQ) { r[ai][m][bj] = w; } }
        if constexpr (SSQ) {
            const int rowb = prow(u.pm) + wr * 64 + fr;
#pragma unroll
            for (int ai = 0; ai < 2; ++ai)
#pragma unroll
                for (int m = 0; m < 4; ++m) { float s = 0.f;
#pragma unroll
                    for (int bj = 0; bj < 2; ++bj) { const u32x4 w = r[ai][m][bj];
#pragma unroll
                        for (int e = 0; e < 4; ++e) { const float x0 = __uint_as_float(w[e] << 16), x1 = __uint_as_float(w[e] & 0xffff0000u); s += x0 * x0 + x1 * x1; } }
                    s += __shfl_xor(s, 16); s += __shfl_xor(s, 32);
                    if (fq == 0) atomicAdd(ssq + rowb + ai * HALF + m * 16, (unsigned long long)(s * 4294967296.0f)); }
        }
    }
};
template <bool I8> struct EpiConv {
    static constexpr bool PERM = true, AFTER_DRAIN = false, APERM = true;
    bf16_t* ACT; float* EDGE; const float* cw; const float* cb; PG8_LAS float* EX; const float* asc; const float* wsc;
    static __device__ __forceinline__ float shr1(float oldv, float src) { return __int_as_float(__builtin_amdgcn_update_dpp(__float_as_int(oldv), __float_as_int(src), 0x111, 0xf, 0xf, false)); }
    __device__ __forceinline__ void operator()(typename AccSel<I8>::type (&acc)[2][2][4][2], const Unit& u, int wr, int wc, int fr_in, int fq_in) const {
        constexpr int NUPc = 22016, DFFc = 11008;
        (void)fr_in; (void)fq_in; int ln_; asm volatile("v_mbcnt_lo_u32_b32 %0, -1, 0\n\tv_mbcnt_hi_u32_b32 %0, -1, %0" : "=v"(ln_));
        int fr = ln_ & 15, fq = ln_ >> 4;
        const int chb = wc * 32 + 8 * fq, prow0 = prow(u.pm);
#define EC_F(ai_, bj_, m_, n_) __builtin_bit_cast(f32x4, acc[ai_][bj_][m_][n_])
        PG8_LAS float* CWL = EX + 2048;
        PG8_LAS float* WSL = EX + 2048 + 1024;
        PG8_LAS float* ASL = EX + 2048 + 1024 + 256;
        {
            const int t_ = (wr * 4 + wc) * 64 + ln_;
            if (t_ < 256) { const int v = t_ >> 5, c4 = (t_ & 31) * 4, vv = v & 3; const float* sp = (vv < 3 ? cw + vv * NUPc : cb) + (v >> 2) * DFFc + u.pn * 128 + c4;
                *(PG8_LAS f32x4*)(CWL + v * 128 + c4) = *(const f32x4*)sp; }
            else if (I8 && t_ < 320) { const int j = t_ - 256; *(PG8_LAS f32x4*)(WSL + 4 * j) = *(const f32x4*)(wsc + u.pn * 256 + 4 * j); }
            else if (I8 && t_ < 384) { const int j = t_ - 320; *(PG8_LAS f32x4*)(ASL + 4 * j) = *(const f32x4*)(asc + prow0 + 4 * j); }
        }
        asm volatile("s_waitcnt vmcnt(0) lgkmcnt(0)" ::: "memory"); __builtin_amdgcn_s_barrier(); asm volatile("" ::: "memory");
        if constexpr (I8) {
            f32x4 as_[2];
#pragma unroll
            for (int ai = 0; ai < 2; ++ai) as_[ai] = *(const PG8_LAS f32x4*)(ASL + 128 * ai + 64 * wr + 4 * fr);
#pragma unroll
            for (int bj = 0; bj < 2; ++bj)
#pragma unroll
                for (int n = 0; n < 2; ++n) { const f32x4 wsv = *(const PG8_LAS f32x4*)(WSL + bj * 128 + chb + 4 * n);
#pragma unroll
                    for (int ai = 0; ai < 2; ++ai)
#pragma unroll
                        for (int m = 0; m < 4; ++m) { const i32x4 q = __builtin_bit_cast(i32x4, acc[ai][bj][m][n]); f32x4 f; f[0] = (float)q[0]; f[1] = (float)q[1]; f[2] = (float)q[2]; f[3] = (float)q[3];
                            f = f * wsv * as_[ai][m]; acc[ai][bj][m][n] = __builtin_bit_cast(typename AccSel<I8>::type, f); } }
        }
        if (fr == 15) {
#pragma unroll
            for (int ai = 0; ai < 2; ++ai)
#pragma unroll
                for (int mm = 2; mm < 4; ++mm)
#pragma unroll
                    for (int bj = 0; bj < 2; ++bj)
#pragma unroll
                        for (int n = 0; n < 2; ++n) *(PG8_LAS f32x4*)(EX + (((2 * ai + wr) * 2 + (mm - 2)) * 256 + bj * 128 + chb + 4 * n)) = EC_F(ai, bj, mm, n);
        }
        char* eg = (char*)(EDGE + (size_t)u.pm * 4 * NUPc + u.pn * 256);
        if (wr == 0 && fr == 0) {
#pragma unroll
            for (int mm = 0; mm < 2; ++mm)
#pragma unroll
                for (int bj = 0; bj < 2; ++bj)
#pragma unroll
                    for (int n = 0; n < 2; ++n) *(f32x4*)(eg + (unsigned)(mm * NUPc + chb) * 4u + (bj * 128 + 4 * n) * 4) = EC_F(0, bj, mm, n);
        }
        if (wr == 1 && fr == 15) {
#pragma unroll
            for (int mm = 2; mm < 4; ++mm)
#pragma unroll
                for (int bj = 0; bj < 2; ++bj)
#pragma unroll
                    for (int n = 0; n < 2; ++n) *(f32x4*)(eg + (unsigned)(mm * NUPc + chb) * 4u + (bj * 128 + 4 * n) * 4) = EC_F(1, bj, mm, n);
        }
        asm volatile("s_waitcnt lgkmcnt(0)" ::: "memory"); __builtin_amdgcn_s_barrier(); asm volatile("" ::: "memory");
        unsigned pk0[2][4][2];
#pragma unroll
        for (int n = 0; n < 2; ++n) {
            asm volatile("" : "+v"(fr));
            const int ch = u.pn * 128 + chb + 4 * n;
            const PG8_LAS float* cwl = CWL + chb + 4 * n;
            const f32x4 wg0 = *(const PG8_LAS f32x4*)cwl, wg1 = *(const PG8_LAS f32x4*)(cwl + 128), wg2 = *(const PG8_LAS f32x4*)(cwl + 256), bg = *(const PG8_LAS f32x4*)(cwl + 384);
            const f32x4 wv0 = *(const PG8_LAS f32x4*)(cwl + 512), wv1 = *(const PG8_LAS f32x4*)(cwl + 640), wv2 = *(const PG8_LAS f32x4*)(cwl + 768), bv = *(const PG8_LAS f32x4*)(cwl + 896);
#pragma unroll
            for (int ai = 0; ai < 2; ++ai) {
                const int q = 2 * ai + wr;
                f32x4 hg1 = {0.f, 0.f, 0.f, 0.f}, hg2 = hg1, hv1 = hg1, hv2 = hg1;
                if (q >= 1) { const PG8_LAS float* hx = EX + ((q - 1) * 2) * 256 + chb + 4 * n;
                    hg2 = *(const PG8_LAS f32x4*)hx; hg1 = *(const PG8_LAS f32x4*)(hx + 256); hv2 = *(const PG8_LAS f32x4*)(hx + 128); hv1 = *(const PG8_LAS f32x4*)(hx + 256 + 128); }
                float o[4][4];
#pragma unroll
                for (int e = 0; e < 4; ++e) {
                    const float g0 = EC_F(ai, 0, 0, n)[e], g1 = EC_F(ai, 0, 1, n)[e], g2 = EC_F(ai, 0, 2, n)[e], g3 = EC_F(ai, 0, 3, n)[e];
                    const float v0 = EC_F(ai, 1, 0, n)[e], v1 = EC_F(ai, 1, 1, n)[e], v2 = EC_F(ai, 1, 2, n)[e], v3 = EC_F(ai, 1, 3, n)[e];
                    const float gm1 = shr1(hg1[e], g3), gm2 = shr1(hg2[e], g2), vm1 = shr1(hv1[e], v3), vm2 = shr1(hv2[e], v2);
                    const float cg0 = bg[e] + wg0[e] * gm2 + wg1[e] * gm1 + wg2[e] * g0, cv0 = bv[e] + wv0[e] * vm2 + wv1[e] * vm1 + wv2[e] * v0;
                    const float cg1 = bg[e] + wg0[e] * gm1 + wg1[e] * g0 + wg2[e] * g1, cv1 = bv[e] + wv0[e] * vm1 + wv1[e] * v0 + wv2[e] * v1;
                    const float cg2 = bg[e] + wg0[e] * g0 + wg1[e] * g1 + wg2[e] * g2, cv2 = bv[e] + wv0[e] * v0 + wv1[e] * v1 + wv2[e] * v2;
                    const float cg3 = bg[e] + wg0[e] * g1 + wg1[e] * g2 + wg2[e] * g3, cv3 = bv[e] + wv0[e] * v1 + wv1[e] * v2 + wv2[e] * v3;
                    o[0][e] = cg0 * __builtin_amdgcn_rcpf(1.0f + __expf(-cg0)) * cv0; o[1][e] = cg1 * __builtin_amdgcn_rcpf(1.0f + __expf(-cg1)) * cv1;
                    o[2][e] = cg2 * __builtin_amdgcn_rcpf(1.0f + __expf(-cg2)) * cv2; o[3][e] = cg3 * __builtin_amdgcn_rcpf(1.0f + __expf(-cg3)) * cv3;
                }
#pragma unroll
                for (int m = 0; m < 4; ++m) {
                    if (n == 0) { pk0[ai][m][0] = cvt_pk_bf16(o[m][0], o[m][1]); pk0[ai][m][1] = cvt_pk_bf16(o[m][2], o[m][3]); }
                    else if (!(q == 0 && fr == 0 && m < 2)) {
                        u32x4 w; w.x = pk0[ai][m][0]; w.y = pk0[ai][m][1]; w.z = cvt_pk_bf16(o[m][0], o[m][1]); w.w = cvt_pk_bf16(o[m][2], o[m][3]);
                        *(u32x4*)(ACT + (size_t)(prow0 + 128 * ai + 64 * wr + 4 * fr + m) * DFFc + (ch - 4)) = w;
                    }
                }
            }
        }
    }
#undef EC_F
};
template <class Epi, class Sched, bool ALIGN_EPI = false, bool SP2 = false, bool I8 = false>
__device__ __forceinline__ void gemm_phase(PG8_LAS unsigned char* lds, const Gemm g, const Sched& S, const Epi& E, const int wave_s) {
    int lane_; asm volatile("v_mbcnt_lo_u32_b32 %0, -1, 0\n\tv_mbcnt_hi_u32_b32 %0, -1, %0" : "=v"(lane_));
    const int wid = wave_s, lane = lane_, tid = wid * 64 + lane, wr = wid >> 2, wc = wid & 3, fr = lane & 15, fq = lane >> 4;
    const int K = g.K, nt = K / BK;
    unsigned voffA[2], voffB[2];
#pragma unroll
    for (int i = 0; i < 2; ++i) { int R, C; stage_rc(tid * 16 + i * 8192, R, C); const int Rb = Epi::PERM ? ((R & ~31) + perm32(R & 31)) : R;
        const int Ra = Epi::APERM ? ((R & ~63) + 4 * (R & 15) + ((R >> 4) & 3)) : R;
        voffA[i] = (unsigned)(Ra * K + C) * 2u; voffB[i] = (unsigned)(Rb * K + C) * 2u; }
    const size_t kstep = (size_t)(BK * 2);
    const size_t hstep = (size_t)HALF * K * 2;
    const size_t tstep = 2 * hstep;
    const unsigned ldsw = (unsigned)wid * 1024u;
    const int aoff = lds_byte(wr * 64 + fr, fq * 8), boff = lds_byte(wc * 32 + fr, fq * 8);
#define PG8_SA(b, h) (((b) * 2 + (h)) * HTB)
#define PG8_SB(b, h) ((4 + (b) * 2 + (h)) * HTB)
#define PG8_STAGE(bufoff, gbase, voff) do { _Pragma("unroll") for (int _i = 0; _i < 2; ++_i) \
        __builtin_amdgcn_global_load_lds((const unsigned*)((const char*)(gbase) + (voff)[_i]), (PG8_LAS unsigned*)(lds + (bufoff) + ldsw + _i * 8192), 16, 0, 0); } while (0)
#define PG8_LDA(dst, b, h) do { _Pragma("unroll") for (int m = 0; m < 4; ++m) _Pragma("unroll") for (int k = 0; k < 2; ++k) dst[m][k] = *(const PG8_LAS bf16x8*)(lds + PG8_SA(b, h) + aoff + m * 2048 + k * 1024); } while (0)
#define PG8_LDB(dst, b, h) do { _Pragma("unroll") for (int n = 0; n < 2; ++n) _Pragma("unroll") for (int k = 0; k < 2; ++k) dst[n][k] = *(const PG8_LAS bf16x8*)(lds + PG8_SB(b, h) + boff + n * 2048 + k * 1024); } while (0)
#define PG8_MMA(ai, bj, At, Bt) do { __builtin_amdgcn_s_setprio(1); _Pragma("unroll") for (int m = 0; m < 4; ++m) _Pragma("unroll") for (int n = 0; n < 2; ++n) _Pragma("unroll") for (int k = 0; k < 2; ++k) { \
        if constexpr (I8) acc[ai][bj][m][n] = __builtin_bit_cast(acc_t, __builtin_amdgcn_mfma_i32_16x16x64_i8(__builtin_bit_cast(i32x4, Bt[n][k]), __builtin_bit_cast(i32x4, At[m][k]), __builtin_bit_cast(i32x4, acc[ai][bj][m][n]), 0, 0, 0)); \
        else acc[ai][bj][m][n] = __builtin_bit_cast(acc_t, __builtin_amdgcn_mfma_f32_16x16x32_bf16(Bt[n][k], At[m][k], __builtin_bit_cast(f32x4, acc[ai][bj][m][n]), 0, 0, 0)); } \
        __builtin_amdgcn_s_setprio(0); } while (0)
#define PG8_WAIT_V(n) asm volatile("s_waitcnt vmcnt(" #n ")" ::: "memory")
#define PG8_WAIT_L(n) asm volatile("s_waitcnt lgkmcnt(" #n ")" ::: "memory")
#define PG8_BAR __builtin_amdgcn_s_barrier()
#define PG8_SCHED __builtin_amdgcn_sched_barrier(0)
    Unit cur, nxt; int ui = 0;
    if (!S.next(0, cur)) return;
    typedef typename AccSel<I8>::type acc_t;
    acc_t acc[2][2][4][2];
#pragma unroll
    for (int a = 0; a < 2; ++a)
#pragma unroll
        for (int b = 0; b < 2; ++b)
#pragma unroll
            for (int m = 0; m < 4; ++m)
#pragma unroll
                for (int n = 0; n < 2; ++n) acc[a][b][m][n] = __builtin_bit_cast(acc_t, (f32x4){0.f, 0.f, 0.f, 0.f});
    bf16x8 At[4][2], B0[2][2], B1[2][2];
    const char* cA = (const char*)g.A + (size_t)prow(cur.pm) * K * 2; const char* cB = (const char*)g.Bt + (size_t)cur.pn * tstep;
    S.a_ready(cur);
    if constexpr (SP2) {
        PG8_STAGE(PG8_SB(0, 0), cB, voffB); PG8_STAGE(PG8_SB(0, 1), cB + hstep, voffB); PG8_STAGE(PG8_SA(0, 0), cA, voffA); PG8_STAGE(PG8_SA(0, 1), cA + hstep, voffA);
        if (wr == 1) PG8_BAR;
        PG8_WAIT_V(2); PG8_BAR;
        PG8_STAGE(PG8_SB(1, 0), cB + kstep, voffB); PG8_STAGE(PG8_SA(1, 0), cA + kstep, voffA); PG8_STAGE(PG8_SB(1, 1), cB + hstep + kstep, voffB);
        PG8_WAIT_V(6); PG8_BAR;
    } else {
        PG8_STAGE(PG8_SB(0, 0), cB, voffB); PG8_STAGE(PG8_SA(0, 0), cA, voffA); PG8_STAGE(PG8_SB(0, 1), cB + hstep, voffB); PG8_STAGE(PG8_SA(0, 1), cA + hstep, voffA);
        if (wr == 1) PG8_BAR;
        PG8_WAIT_V(4); PG8_BAR;
        PG8_STAGE(PG8_SB(1, 0), cB + kstep, voffB); PG8_STAGE(PG8_SA(1, 0), cA + kstep, voffA); PG8_STAGE(PG8_SB(1, 1), cB + hstep + kstep, voffB);
        PG8_WAIT_V(6); PG8_BAR;
    }
    for (;;) {
        const bool has_next = S.next(ui + 1, nxt);
        const char* nA = has_next ? (const char*)g.A + (size_t)prow(nxt.pm) * K * 2 : cA; const char* nB = has_next ? (const char*)g.Bt + (size_t)nxt.pn * tstep : cB;
        for (int t = 0; t < nt; t += 2) {
            const bool last = (t == nt - 2);
            const char* a1 = cA + (size_t)(t + 1) * kstep;
            const char* a2 = last ? nA : cA + (size_t)(t + 2) * kstep; const char* b2 = last ? nB : cB + (size_t)(t + 2) * kstep;
            const char* a3 = a2 + kstep; const char* b3 = b2 + kstep;
            if (last && has_next) S.a_ready(nxt);
            if constexpr (SP2) {
            PG8_LDB(B0, 0, 0); PG8_LDB(B1, 0, 1); PG8_SCHED; PG8_LDA(At, 0, 0); PG8_STAGE(PG8_SA(1, 1), a1 + hstep, voffA);
            PG8_WAIT_V(8); PG8_WAIT_L(0); PG8_BAR; PG8_MMA(0, 0, At, B0); PG8_MMA(0, 1, At, B1); PG8_BAR; PG8_SCHED;
            PG8_LDA(At, 0, 1); PG8_STAGE(PG8_SB(0, 0), b2, voffB); PG8_STAGE(PG8_SB(0, 1), b2 + hstep, voffB); PG8_STAGE(PG8_SA(0, 0), a2, voffA);
            PG8_WAIT_V(8); PG8_WAIT_L(0); PG8_BAR; PG8_MMA(1, 0, At, B0); PG8_MMA(1, 1, At, B1); PG8_BAR; PG8_SCHED;
            PG8_LDB(B0, 1, 0); PG8_LDB(B1, 1, 1); PG8_SCHED; PG8_LDA(At, 1, 0); PG8_STAGE(PG8_SA(0, 1), a2 + hstep, voffA);
            PG8_WAIT_V(8); PG8_WAIT_L(0); PG8_BAR; PG8_MMA(0, 0, At, B0); PG8_MMA(0, 1, At, B1); PG8_BAR; PG8_SCHED;
            PG8_LDA(At, 1, 1); PG8_STAGE(PG8_SB(1, 0), b3, voffB); PG8_STAGE(PG8_SB(1, 1), b3 + hstep, voffB); PG8_STAGE(PG8_SA(1, 0), a3, voffA);
            PG8_WAIT_V(8); PG8_WAIT_L(0); PG8_BAR; PG8_MMA(1, 0, At, B0); PG8_MMA(1, 1, At, B1); PG8_BAR; PG8_SCHED;
            } else {
            PG8_LDB(B0, 0, 0); PG8_SCHED; PG8_LDA(At, 0, 0); PG8_STAGE(PG8_SA(1, 1), a1 + hstep, voffA);
            PG8_WAIT_L(8); PG8_BAR; PG8_WAIT_L(0); PG8_MMA(0, 0, At, B0); PG8_BAR; PG8_SCHED;
            PG8_LDB(B1, 0, 1); PG8_STAGE(PG8_SB(0, 0), b2, voffB);
            PG8_BAR; PG8_WAIT_L(0); PG8_MMA(0, 1, At, B1); PG8_BAR;
            PG8_LDA(At, 0, 1); PG8_STAGE(PG8_SA(0, 0), a2, voffA);
            PG8_BAR; PG8_WAIT_L(0); PG8_MMA(1, 0, At, B0); PG8_BAR; PG8_SCHED;
            PG8_STAGE(PG8_SB(0, 1), b2 + hstep, voffB);
            PG8_WAIT_V(6); PG8_BAR; PG8_MMA(1, 1, At, B1); PG8_BAR;
            PG8_LDB(B0, 1, 0); PG8_SCHED; PG8_LDA(At, 1, 0); PG8_STAGE(PG8_SA(0, 1), a2 + hstep, voffA);
            PG8_WAIT_L(8); PG8_BAR; PG8_WAIT_L(0); PG8_MMA(0, 0, At, B0); PG8_BAR; PG8_SCHED;
            PG8_LDB(B1, 1, 1); PG8_STAGE(PG8_SB(1, 0), b3, voffB);
            PG8_BAR; PG8_WAIT_L(0); PG8_MMA(0, 1, At, B1); PG8_BAR;
            PG8_LDA(At, 1, 1); PG8_STAGE(PG8_SA(1, 0), a3, voffA);
            PG8_BAR; PG8_WAIT_L(0); PG8_MMA(1, 0, At, B0); PG8_BAR; PG8_SCHED;
            PG8_STAGE(PG8_SB(1, 1), b3 + hstep, voffB);
            PG8_WAIT_V(6); PG8_BAR; PG8_MMA(1, 1, At, B1); PG8_BAR;
            }
        }
        if constexpr (ALIGN_EPI) { if (wr == 0) PG8_BAR; }
        if constexpr (!Epi::AFTER_DRAIN) { E(acc, cur, wr, wc, fr, fq); S.done(cur); }
        if (!has_next) break;
#pragma unroll
        for (int a = 0; a < 2; ++a)
#pragma unroll
            for (int b = 0; b < 2; ++b)
#pragma unroll
                for (int m = 0; m < 4; ++m)
#pragma unroll
                    for (int n = 0; n < 2; ++n) acc[a][b][m][n] = __builtin_bit_cast(acc_t, (f32x4){0.f, 0.f, 0.f, 0.f});
        cur = nxt; cA = nA; cB = nB; ++ui;
        if constexpr (ALIGN_EPI) { if (wr == 1) PG8_BAR; }
    }
    PG8_WAIT_V(0);
    if constexpr (!ALIGN_EPI) { if (wr == 0) PG8_BAR; }
    PG8_BAR;
    if constexpr (Epi::AFTER_DRAIN) { E.fused(acc, cur, wr, wc, fr, fq, lds, wid, lane); S.done(cur); }
#undef PG8_SA
#undef PG8_SB
#undef PG8_STAGE
#undef PG8_LDA
#undef PG8_LDB
#undef PG8_MMA
#undef PG8_WAIT_V
#undef PG8_WAIT_L
#undef PG8_BAR
#undef PG8_SCHED
}
}

#define LAS __attribute__((address_space(3)))
#define XB_TMO      128
#define XB_XCNT(j)  (256  + 64 * (j))
#define XB_XSUB(j)  (1280 + 64 * (j))
#define XB_XGEN(j)  (2304 + 64 * (j))
#define XB_TOP      3328
#define XB_TOPGEN   3392
#define XCD_BAR_WORDS 3456
#define XB_SPIN_CAP (1u << 18)

__device__ __forceinline__ unsigned xb_ld(unsigned* p)              { return __hip_atomic_load(p, __ATOMIC_RELAXED, __HIP_MEMORY_SCOPE_AGENT); }
__device__ __forceinline__ unsigned xb_add(unsigned* p, unsigned v) { return __hip_atomic_fetch_add(p, v, __ATOMIC_RELAXED, __HIP_MEMORY_SCOPE_AGENT); }
__device__ __forceinline__ unsigned xb_xcc_id() { return (unsigned)__builtin_amdgcn_s_getreg((3 << 11) | 20) & 0xFu; }
#define XB_SPIN(cond, bar) do { unsigned _sp = 0; while (cond) { __builtin_amdgcn_s_sleep(1); \
    if ((++_sp & 255u) == 0u) { if (xb_ld(&(bar)[XB_TMO])) break; if (_sp > XB_SPIN_CAP) { atomicAdd(&(bar)[XB_TMO], 1u); break; } } } } while (0)

struct XcdBarrier {
    unsigned* bar; unsigned x; unsigned w0;
    volatile LAS unsigned* st;
};

__device__ __forceinline__ XcdBarrier xcd_barrier_post(unsigned* bar, volatile LAS unsigned* st) {
    XcdBarrier b; b.bar = bar; b.x = xb_xcc_id(); b.st = st; b.w0 = threadIdx.x < 64 ? 1u : 0u;
    if (threadIdx.x == 0) (void)xb_add(&bar[XB_XCNT(b.x)], 1u);
    return b;
}
__device__ __forceinline__ void xcd_barrier_complete(unsigned* bar, unsigned x, unsigned& nloc, unsigned& nx) {
    const unsigned G = gridDim.x * gridDim.y * gridDim.z;
    unsigned sum, cnt, mine, sp = 0u;
    for (;;) {
        sum = 0u; cnt = 0u; mine = 0u;
#pragma unroll
        for (unsigned j = 0; j < 16; ++j) { const unsigned c = xb_ld(&bar[XB_XCNT(j)]); sum += c; cnt += (c > 0u) ? 1u : 0u; mine = (j == x) ? c : mine; }
        if (sum == G) break;
        __builtin_amdgcn_s_sleep(1);
        if ((++sp & 255u) == 0u) { if (xb_ld(&bar[XB_TMO])) break; if (sp > XB_SPIN_CAP) { atomicAdd(&bar[XB_TMO], 1u); break; } }
    }
    nloc = mine > 0u ? mine : 1u; nx = cnt > 0u ? cnt : 1u;
}

__device__ __forceinline__ void xcd_barrier(const XcdBarrier& b) {
    asm volatile("s_waitcnt vmcnt(0)" ::: "memory");
    __syncthreads();
    int xb_lane; asm volatile("v_mbcnt_lo_u32_b32 %0, -1, 0\n\tv_mbcnt_hi_u32_b32 %0, -1, %0" : "=v"(xb_lane));
    if (b.w0 != 0u && xb_lane == 0) {
        unsigned* bar = b.bar;
        __builtin_amdgcn_s_waitcnt(0);
        unsigned nloc = b.st[0], nx = b.st[1];
        if (nloc == 0u) { xcd_barrier_complete(bar, b.x, nloc, nx); b.st[0] = nloc; b.st[1] = nx; }
        const unsigned old = xb_add(&bar[XB_XSUB(b.x)], 1u);
        const unsigned gen = old / nloc;
        if (old + 1u == (gen + 1u) * nloc) {
            __builtin_amdgcn_fence(__ATOMIC_RELEASE, "agent");
            asm volatile("s_waitcnt vmcnt(0)" ::: "memory");
            const unsigned og = xb_add(&bar[XB_TOP], 1u);
            const unsigned tg = og / nx;
            if (og + 1u == (tg + 1u) * nx) xb_add(&bar[XB_TOPGEN], 1u);
            else XB_SPIN(xb_ld(&bar[XB_TOPGEN]) == tg, bar);
            __builtin_amdgcn_fence(__ATOMIC_ACQUIRE, "agent");
            xb_add(&bar[XB_XGEN(b.x)], 1u);
            asm volatile("s_waitcnt vmcnt(0)" ::: "memory");
        } else {
            XB_SPIN(xb_ld(&bar[XB_XGEN(b.x)]) == gen, bar);
            __builtin_amdgcn_fence(__ATOMIC_ACQUIRE, "agent");
            asm volatile("s_waitcnt vmcnt(0)" ::: "memory");
        }
    }
    __syncthreads();
}

typedef pg8::bf16_t bf16_t; typedef pg8::bf16x8 bf16x8; typedef pg8::f32x4 f32x4; typedef pg8::u32x4 u32x4;
typedef unsigned u32x2 __attribute__((ext_vector_type(2)));
constexpr int NB = 2, SEQ = 4096, LEAD = 128, LL = 4224, NPAD = 112, R = NB * LL, DM = 4096;
constexpr int NPROJ = 9728, NIN = 9984, NSM = 256, DFF = 11008, NUP = 22016, NQ = 2304, NKV = 3072;
constexpr int GCH = 66, GUNITS = NB * 4 * GCH;
constexpr float EPS = 1e-6f;
constexpr int PC_FQ = 2048, PC_FK = 3584, PC_FV = 5120, PC_GQ = 6656, PC_GK = 7168, PC_GV = 7680, PC_GR = 8704;

constexpr size_t MiB = 1u << 20;
constexpr size_t al(size_t x) { return (x + MiB - 1) / MiB * MiB; }
constexpr size_t WS_CTL = 0, CTL_ZERO_BYTES = MiB;
constexpr size_t WS_CS = 1 * MiB;
constexpr size_t WS_W = 4 * MiB;
constexpr size_t SZ_WIN = (size_t)NIN * DM * 2, SZ_WUQ = (size_t)NQ * 1536 * 2, SZ_WUKV = (size_t)NKV * 512 * 2, SZ_WOUT = (size_t)DM * DM * 2, SZ_WUP = (size_t)NUP * DM * 2, SZ_WDN = (size_t)DM * DFF * 2;
constexpr size_t OFF_WIN = 0, OFF_WUQ = OFF_WIN + al(SZ_WIN), OFF_WUKV = OFF_WUQ + al(SZ_WUQ), OFF_WOUT = OFF_WUKV + al(SZ_WUKV), OFF_WUP = OFF_WOUT + al(SZ_WOUT), OFF_WDN = OFF_WUP + al(SZ_WUP), SZ_WLAYER = OFF_WDN + al(SZ_WDN);
constexpr size_t WS_H = WS_W + 2 * SZ_WLAYER;
constexpr size_t WS_HN = WS_H + al((size_t)R * DM * 4);
constexpr size_t WS_PROJ = WS_HN + al((size_t)R * DM * 2);
constexpr size_t WS_SMALL = WS_PROJ + al((size_t)R * NPROJ * 2);
constexpr size_t WS_CQN = WS_SMALL + al((size_t)R * NSM * 4);
constexpr size_t WS_CKVN = WS_CQN + al((size_t)R * 1536 * 2);
constexpr size_t WS_KPE = WS_CKVN + al((size_t)R * 512 * 2);
constexpr size_t WS_LOGA = WS_KPE + al((size_t)R * 64 * 2);
constexpr size_t WS_LOGF = WS_LOGA + al((size_t)R * 512 * 4);
constexpr size_t WS_CF = WS_LOGF + al((size_t)R * 16 * 4);
constexpr size_t WS_QM = WS_CF + al((size_t)NB * 12 * LL * 4);
constexpr size_t WS_KVM = WS_QM + al((size_t)R * NQ * 2);
constexpr size_t WS_OG = WS_KVM + al((size_t)R * NKV * 2);
constexpr size_t WS_UB = WS_OG + al((size_t)R * DM * 4);
constexpr size_t WS_DEC = WS_UB + al((size_t)GUNITS * 128 * 256 * 4);
constexpr size_t WS_QDG = WS_DEC + al((size_t)GUNITS * 128 * 4);
constexpr size_t WS_SPT = WS_QDG + al((size_t)R * 512 * 2);
constexpr size_t WS_MIX = WS_SPT + al((size_t)GUNITS * 256 * 128 * 2);
constexpr size_t WS_EDGE = WS_MIX + al((size_t)R * DM * 2);
constexpr size_t WS_UM = WS_EDGE + al((size_t)32 * 4 * NUP * 4);
constexpr size_t WS_ACT = WS_UM + al((size_t)16 * NUP * 4);
constexpr size_t WS_WQ = WS_ACT + al((size_t)R * DFF * 2);
constexpr size_t SZ_WQ = (size_t)NUP * DM;
constexpr size_t WS_HNQ = WS_WQ + al(2 * SZ_WQ);
constexpr size_t WS_ASC = WS_HNQ + al((size_t)R * DM);
constexpr size_t WS_WSC = WS_ASC + MiB;
constexpr size_t WS_KN2 = WS_WSC + MiB;
constexpr size_t WS_KPM = WS_KN2 + al((size_t)R * 16 * 4);
constexpr size_t WS_END = WS_KPM + MiB;
constexpr int CW_BAR = 4096;
static_assert((CW_BAR + XCD_BAR_WORDS) * 4 <= (int)CTL_ZERO_BYTES, "ctl");
constexpr size_t WS_WMAX = 262144;
static_assert(WS_WMAX + 2 * NUP * 4 <= CTL_ZERO_BYTES, "wmax");
constexpr size_t WS_SS0 = 524288, WS_SS1 = 655360;
static_assert(WS_SS0 >= WS_WMAX + 2 * NUP * 4 && WS_SS0 + (size_t)R * 8 <= WS_SS1 && WS_SS1 + (size_t)R * 8 <= CTL_ZERO_BYTES, "ss");
constexpr float SS_FIX = 4294967296.0f, SS_UNFIX = 1.0f / 4294967296.0f;
constexpr int RING_BYTES = 131072, MISC_OFF = RING_BYTES, LDS_BYTES = 147456;

__device__ __forceinline__ float bf2f(bf16_t b) { return __uint_as_float(((unsigned)b) << 16); }
__device__ __forceinline__ bf16_t f2bf(float f) { unsigned u = __float_as_uint(f); u += 0x7fffu + ((u >> 16) & 1u); return (bf16_t)(u >> 16); }
__device__ __forceinline__ unsigned pk2(float lo, float hi) { return (unsigned)f2bf(lo) | ((unsigned)f2bf(hi) << 16); }
__device__ __forceinline__ float wave_sum(float v) {
#pragma unroll
    for (int o = 1; o < 64; o <<= 1) v += __shfl_xor(v, o);
    return v;
}
__device__ __forceinline__ float logsig(float x) { return fminf(x, 0.f) - log1pf(expf(-fabsf(x))); }
#define LDS_WAIT() asm volatile("s_waitcnt lgkmcnt(0)" ::: "memory")

struct Args { const float* in[21]; float* out; unsigned char* ws; int ph_lo, ph_hi; };
#define WSP(T, off) ((T*)(a.ws + (off)))

__device__ __forceinline__ int map_in(int n) {
    if (n < 2048) return n;
    if (n < 3584) return 5200 + (n - 2048);
    if (n < 5120) return 6736 + (n - 3584);
    if (n < 6656) return 8272 + (n - 5120);
    if (n < 7168) return 2112 + (n - 6656);
    if (n < 7680) return 2624 + (n - 7168);
    if (n < 8704) return 3136 + (n - 7680);
    if (n < 9728) return 4176 + (n - 8704);
    if (n < 9792) { const int j = n - 9728; return 2048 + (j & 1) * 32 + (j >> 1); }
    if (n < 9808) return 4160 + (n - 9792);
    if (n < 9820) return n;
    return -1;
}
__device__ __forceinline__ int map_uq(int n) {
    if (n < 1536) return (n >> 7) * 192 + (n & 127);
    const int j = n - 1536, h = j >> 6, jj = j & 63; return h * 192 + 128 + (jj & 1) * 32 + (jj >> 1);
}
__device__ __forceinline__ int map_up(int n) { const int pn = n >> 8, w = n & 255; return w < 128 ? 128 * pn + w : DFF + 128 * pn + (w - 128); }
__device__ __forceinline__ int map_ukv(int n) {
    if (n < 1536) return (n >> 7) * 256 + (n & 127);
    const int j = n - 1536; return (j >> 7) * 256 + 128 + (j & 127);
}
template <int MAP, int GM>
__device__ __forceinline__ void prep_item(const float* W, int Nsrc, bf16_t* WT, int K, int Ndst, const float* g0, const float* g1, const float* g2, LAS float* scr, int item, int lane, float* wmax = nullptr) {
    const int nblk = Ndst / 32, kb = item / nblk, nb = item % nblk, k0 = 128 * kb, n0 = 32 * nb;
    const int n = n0 + (lane & 31);
    const int src = MAP == 0 ? n : MAP == 1 ? map_in(n) : MAP == 2 ? map_uq(n) : MAP == 3 ? map_ukv(n) : map_up(n);
    float vv[64];
#pragma unroll
    for (int i = 0; i < 64; ++i) { const int k = k0 + 2 * i + (lane >> 5); vv[i] = src >= 0 ? __builtin_nontemporal_load(W + (size_t)k * Nsrc + src) : 0.f; }
    const int c = lane & 7;
#pragma unroll
    for (int h = 0; h < 2; ++h) {
#pragma unroll
        for (int i = 0; i < 32; ++i) { const int kk = 2 * i + (lane >> 5), k = k0 + 64 * h + kk; float v = vv[32 * h + i];
            if (GM == 1) v *= g0[k];
            if (GM == 2) v *= (k < 1536 ? g0[k] : k < 2560 ? g1[k - 1536] : g2[k - 2560]);
            scr[kk * 33 + (lane & 31)] = v; }
        LDS_WAIT(); asm volatile("" ::: "memory");
#pragma unroll
        for (int j = 0; j < 4; ++j) { const int nn = (lane >> 3) + 8 * j; const LAS float* s = scr + (8 * c) * 33 + nn;
            u32x4 o; o.x = pk2(s[0 * 33], s[1 * 33]); o.y = pk2(s[2 * 33], s[3 * 33]); o.z = pk2(s[4 * 33], s[5 * 33]); o.w = pk2(s[6 * 33], s[7 * 33]);
            *(u32x4*)(WT + (size_t)(n0 + nn) * K + k0 + 64 * h + 8 * c) = o; }
        LDS_WAIT(); asm volatile("" ::: "memory");
    }
    (void)wmax;
}
__device__ const double INVF[32] = {1.0, 0.7498942093324559, 0.5623413251903491, 0.4216965034285822, 0.31622776601683794, 0.23713737056616552, 0.1778279410038923, 0.1333521432163324, 0.1, 0.07498942093324558, 0.05623413251903491, 0.042169650342858224, 0.03162277660168379, 0.023713737056616554, 0.01778279410038923, 0.01333521432163324, 0.01, 0.007498942093324558, 0.005623413251903491, 0.004216965034285823, 0.0031622776601683794, 0.0023713737056616554, 0.0017782794100389228, 0.001333521432163324, 0.001, 0.0007498942093324559, 0.0005623413251903491, 0.00042169650342858224, 0.00031622776601683794, 0.00023713737056616554, 0.00017782794100389227, 0.0001333521432163324};

__device__ __forceinline__ f32x4 bf4(unsigned lo, unsigned hi) { f32x4 r; r[0] = __uint_as_float(lo << 16); r[1] = __uint_as_float(lo & 0xffff0000u); r[2] = __uint_as_float(hi << 16); r[3] = __uint_as_float(hi & 0xffff0000u); return r; }
template <int MODE>
__device__ __forceinline__ void norm_rows(const Args& a, const float* gain, int gw, int NGW, int lane) {
    for (int row = gw; row < R; row += NGW) {
        const int b = row / LL, p = row - b * LL;
        if (MODE == 2 && p < LEAD) continue;
        f32x4 v[16];
        u32x4* hrow = (u32x4*)(WSP(bf16_t, WS_H) + (size_t)row * DM);
        if (MODE == 0) {
            const float* src = p < NPAD ? nullptr : p < LEAD ? a.in[1] + (size_t)(p - NPAD) * DM : a.in[0] + ((size_t)b * SEQ + (p - LEAD)) * DM;
#pragma unroll
            for (int j = 0; j < 16; ++j) v[j] = src ? *((const f32x4*)src + 128 * (j >> 1) + 2 * lane + (j & 1)) : (f32x4){0.f, 0.f, 0.f, 0.f};
#pragma unroll
            for (int j = 0; j < 8; ++j) { u32x4 w; w.x = pk2(v[2 * j].x, v[2 * j].y); w.y = pk2(v[2 * j].z, v[2 * j].w); w.z = pk2(v[2 * j + 1].x, v[2 * j + 1].y); w.w = pk2(v[2 * j + 1].z, v[2 * j + 1].w); hrow[64 * j + lane] = w; }
        } else {
            u32x4 q[8];
#pragma unroll
            for (int j = 0; j < 8; ++j) q[j] = hrow[64 * j + lane];
#pragma unroll
            for (int j = 0; j < 8; ++j) { v[2 * j] = bf4(q[j].x, q[j].y); v[2 * j + 1] = bf4(q[j].z, q[j].w); }
        }
        float ss = 0.f;
#pragma unroll
        for (int j = 0; j < 16; ++j) ss += (v[j].x * v[j].x + v[j].y * v[j].y) + (v[j].z * v[j].z + v[j].w * v[j].w);
        const float sst = wave_sum(ss);
        if (MODE == 0) { if (lane == 0) ((unsigned long long*)(a.ws + WS_SS0))[row] = (unsigned long long)(sst * SS_FIX); continue; }
        const float rs = 1.0f / sqrtf(sst * (1.0f / DM) + EPS);
        if (MODE == 3) {
            float am = 0.f;
#pragma unroll
            for (int j = 0; j < 16; ++j) am = fmaxf(fmaxf(am, fmaxf(fabsf(v[j].x), fabsf(v[j].y))), fmaxf(fabsf(v[j].z), fabsf(v[j].w)));
#pragma unroll
            for (int o = 1; o < 64; o <<= 1) am = fmaxf(am, __shfl_xor(am, o));
            const float qi = am > 0.f ? 127.0f / am : 0.f;
            u32x2* oq = (u32x2*)(a.ws + WS_HNQ + (size_t)row * DM);
#pragma unroll
            for (int j = 0; j < 8; ++j) { u32x2 w;
#pragma unroll
                for (int h = 0; h < 2; ++h) { const f32x4 x = v[2 * j + h]; const int q0 = (int)rintf(x.x * qi), q1 = (int)rintf(x.y * qi), q2 = (int)rintf(x.z * qi), q3 = (int)rintf(x.w * qi);
                    w[h] = (unsigned)(q0 & 255) | ((unsigned)(q1 & 255) << 8) | ((unsigned)(q2 & 255) << 16) | ((unsigned)(q3 & 255) << 24); }
                oq[64 * j + lane] = w; }
            if (lane == 0) WSP(float, WS_ASC)[row] = rs * am * (1.0f / 127.0f);
            if (p >= NPAD && p < LEAD) { u32x4* o = (u32x4*)(WSP(bf16_t, WS_HN) + (size_t)row * DM);
#pragma unroll
                for (int j = 0; j < 8; ++j) { u32x4 w; w.x = pk2(v[2 * j].x * rs, v[2 * j].y * rs); w.y = pk2(v[2 * j].z * rs, v[2 * j].w * rs); w.z = pk2(v[2 * j + 1].x * rs, v[2 * j + 1].y * rs); w.w = pk2(v[2 * j + 1].z * rs, v[2 * j + 1].w * rs); o[64 * j + lane] = w; } }
        } else if (MODE == 2) {
            float* o = a.out + ((size_t)b * SEQ + (p - LEAD)) * DM;
#pragma unroll
            for (int j = 0; j < 16; ++j) { const int idx = 128 * (j >> 1) + 2 * lane + (j & 1); const f32x4 g = *((const f32x4*)gain + idx); *((f32x4*)o + idx) = v[j] * rs * g; }
        } else {
            u32x4* o = (u32x4*)(WSP(bf16_t, WS_HN) + (size_t)row * DM);
#pragma unroll
            for (int j = 0; j < 8; ++j) { u32x4 w; w.x = pk2(v[2 * j].x * rs, v[2 * j].y * rs); w.y = pk2(v[2 * j].z * rs, v[2 * j].w * rs); w.z = pk2(v[2 * j + 1].x * rs, v[2 * j + 1].y * rs); w.w = pk2(v[2 * j + 1].z * rs, v[2 * j + 1].w * rs); o[64 * j + lane] = w; }
        }
    }
}

__device__ __forceinline__ void prep_wup_strip(const Args& a, LAS unsigned char* lds, int strip, int tid, const int wave_s) {
    const int l = strip / (NUP / 32), n0 = (strip % (NUP / 32)) * 32;
    { int t0; asm volatile("v_mbcnt_lo_u32_b32 %0, -1, 0\n\tv_mbcnt_hi_u32_b32 %0, -1, %0" : "=v"(t0)); tid = t0 + wave_s * 64; }
    const int col = tid & 31, rg = tid >> 5;
    const char* Wu = (const char*)(a.in[16] + (size_t)l * DM * NUP);
    const unsigned loff = (unsigned)(map_up(n0 + col) + 4 * rg * NUP) * 4u;
    LAS float* GL = (LAS float*)lds;
    LAS float* RED = (LAS float*)(lds + 16384);
    LAS unsigned* T = (LAS unsigned*)(lds + 16384 + 2048);
    __syncthreads();
    for (int i = tid; i < DM / 4; i += 512) ((LAS f32x4*)GL)[i] = ((const f32x4*)(a.in[15] + (size_t)l * DM))[i];
    __syncthreads();
    unsigned pk[64][2];
    float amax = 0.f;
#pragma unroll
    for (int i0 = 0; i0 < 64; i0 += 8) {
        float v[32];
#pragma unroll
        for (int j = 0; j < 32; ++j) v[j] = __builtin_nontemporal_load((const float*)(Wu + (size_t)(64 * (i0 + (j >> 2)) + (j & 3)) * NUP * 4 + loff));
#pragma unroll
        for (int j4 = 0; j4 < 8; ++j4) { const f32x4 gg = *(const LAS f32x4*)(GL + 64 * (i0 + j4) + 4 * rg);
            const unsigned w0 = pk2(v[4 * j4] * gg[0], v[4 * j4 + 1] * gg[1]), w1 = pk2(v[4 * j4 + 2] * gg[2], v[4 * j4 + 3] * gg[3]);
            { unsigned o0 = w0, o1 = w1; asm volatile("" : "+v"(o0), "+v"(o1)); pk[i0 + j4][0] = o0; pk[i0 + j4][1] = o1; }
            amax = fmaxf(fmaxf(amax, fmaxf(fabsf(__uint_as_float(w0 << 16)), fabsf(__uint_as_float(w0 & 0xffff0000u)))), fmaxf(fabsf(__uint_as_float(w1 << 16)), fabsf(__uint_as_float(w1 & 0xffff0000u)))); }
        asm volatile("" ::: "memory");
    }
    int tq; asm volatile("v_mbcnt_lo_u32_b32 %0, -1, 0\n\tv_mbcnt_hi_u32_b32 %0, -1, %0" : "=v"(tq)); tq += wave_s * 64;
    const int col2 = tq & 31, rg2 = tq >> 5;
    RED[rg2 * 32 + col2] = amax;
    __syncthreads();
    float am = 0.f;
#pragma unroll
    for (int r = 0; r < 16; ++r) am = fmaxf(am, RED[r * 32 + col2]);
    const float qi = am > 0.f ? 127.0f / am : 0.f;
    if (rg2 == 0) WSP(float, WS_WSC)[(size_t)l * NUP + n0 + col2] = am * (1.0f / 127.0f);
    char* WQ = (char*)(a.ws + WS_WQ + (size_t)l * SZ_WQ + (size_t)n0 * DM);
    const unsigned woff = (unsigned)((tq >> 4) * DM + 16 * (tq & 15)), tw = (unsigned)(col2 * 65 + rg2), tr = (unsigned)((tq >> 4) * 65 + 4 * (tq & 15));
#pragma unroll
    for (int c = 0; c < 16; ++c) {
        LAS unsigned* Tb = T + (c & 1) * (32 * 65);
#pragma unroll
        for (int ii = 0; ii < 4; ++ii) { const unsigned w0 = pk[4 * c + ii][0], w1 = pk[4 * c + ii][1];
            const int q0 = (int)rintf(__uint_as_float(w0 << 16) * qi), q1 = (int)rintf(__uint_as_float(w0 & 0xffff0000u) * qi), q2 = (int)rintf(__uint_as_float(w1 << 16) * qi), q3 = (int)rintf(__uint_as_float(w1 & 0xffff0000u) * qi);
            Tb[tw + 16 * ii] = (unsigned)(q0 & 255) | ((unsigned)(q1 & 255) << 8) | ((unsigned)(q2 & 255) << 16) | ((unsigned)(q3 & 255) << 24); }
        __syncthreads();
        { const LAS unsigned* s = Tb + tr; u32x4 w; w.x = s[0]; w.y = s[1]; w.z = s[2]; w.w = s[3];
          *(u32x4*)(WQ + woff + 256 * c) = w; }
    }
}
__device__ __forceinline__ void phase_prologue(const Args& a, LAS unsigned char* lds, int tid, int lane, int wave) {
    LAS float* scr = (LAS float*)(lds + wave * 16384);
    const int gw = blockIdx.x * 8 + wave, NGW = gridDim.x * 8;
    constexpr int I_IN = (DM / 128) * (NIN / 32), I_UQ = (1536 / 128) * (NQ / 32), I_UKV = (512 / 128) * (NKV / 32), I_OUT = (DM / 128) * (DM / 32), I_DN = (DFF / 128) * (DM / 32);
    static_assert(DFF % 128 == 0 && 1536 % 128 == 0, "item k extent");
    constexpr int I_LAYER = I_IN + I_UQ + I_UKV + I_OUT + I_DN;
    for (int it = gw; it < 2 * I_LAYER; it += NGW) {
        const int l = it / I_LAYER; int r = it - l * I_LAYER;
        unsigned char* wb = a.ws + WS_W + (size_t)l * SZ_WLAYER;
        if (r < I_IN) { prep_item<1, 1>(a.in[3] + (size_t)l * DM * 9820, 9820, (bf16_t*)(wb + OFF_WIN), DM, NIN, a.in[2] + l * DM, nullptr, nullptr, scr, r, lane); continue; } r -= I_IN;
        if (r < I_UQ) { prep_item<2, 1>(a.in[5] + (size_t)l * 1536 * 2304, 2304, (bf16_t*)(wb + OFF_WUQ), 1536, NQ, a.in[4] + l * 1536, nullptr, nullptr, scr, r, lane); continue; } r -= I_UQ;
        if (r < I_UKV) { prep_item<3, 1>(a.in[7] + (size_t)l * 512 * 3072, 3072, (bf16_t*)(wb + OFF_WUKV), 512, NKV, a.in[6] + l * 512, nullptr, nullptr, scr, r, lane); continue; } r -= I_UKV;
        if (r < I_OUT) { prep_item<0, 2>(a.in[14] + (size_t)l * DM * DM, DM, (bf16_t*)(wb + OFF_WOUT), DM, DM, a.in[11] + l * 1536, a.in[12] + l * 1024, a.in[13] + l * 1536, scr, r, lane); continue; } r -= I_OUT;
        prep_item<0, 0>(a.in[19] + (size_t)l * DFF * DM, DM, (bf16_t*)(wb + OFF_WDN), DFF, DM, nullptr, nullptr, nullptr, scr, r, lane);
    }
    for (int e = blockIdx.x * 512 + tid; e < LL * 32; e += gridDim.x * 512) {
        const int p = e >> 5, i = e & 31; const int pos = p > NPAD ? p - NPAD : 0;
        const double ang = (double)pos * INVF[i]; const double kr = rint(ang * 0.15915494309189535); const float rr = (float)(ang - kr * 6.283185307179586);
        WSP(float, WS_CS)[2 * e] = cosf(rr); WSP(float, WS_CS)[2 * e + 1] = sinf(rr);
    }
    norm_rows<0>(a, nullptr, gw, NGW, lane);
}

__device__ __forceinline__ void phase_wquant(const Args& a, int layer, int gw, int NGW, int lane) {
    const bf16_t* Wt = (const bf16_t*)(a.ws + WS_W + (size_t)layer * SZ_WLAYER + OFF_WUP); const float* wmax = (const float*)(a.ws + WS_WMAX) + (size_t)layer * NUP;
    unsigned char* WQ = a.ws + WS_WQ + (size_t)layer * SZ_WQ; float* wsc = WSP(float, WS_WSC) + (size_t)layer * NUP;
    for (int n = gw; n < NUP; n += NGW) {
        const float am = wmax[n], qi = am > 0.f ? 127.0f / am : 0.f;
        if (lane == 0) wsc[n] = am * (1.0f / 127.0f);
#pragma unroll
        for (int j = 0; j < 8; ++j) { const int c = lane + 64 * j; const bf16x8 raw = *(const bf16x8*)(Wt + (size_t)n * DM + c * 8); unsigned w0 = 0u, w1 = 0u;
#pragma unroll
            for (int e = 0; e < 4; ++e) { const int q = (int)rintf(bf2f((bf16_t)raw[e]) * qi); w0 |= (unsigned)(q & 255) << (8 * e); }
#pragma unroll
            for (int e = 0; e < 4; ++e) { const int q = (int)rintf(bf2f((bf16_t)raw[4 + e]) * qi); w1 |= (unsigned)(q & 255) << (8 * e); }
            u32x2 w; w.x = w0; w.y = w1; *(u32x2*)(WQ + (size_t)n * DM + c * 8) = w; }
    }
}

__device__ __forceinline__ void phase_prep_rows(const Args& a, int layer, int gw, int NGW, int lane_in) {
    const float* W2 = a.in[8] + (size_t)layer * 16 * 512; const float* bG = a.in[9] + layer * 512; const float* bF = a.in[10] + layer * 12;
    for (int row = gw; row < R; row += NGW) {
        const int p = row % LL; const bool valid = p >= NPAD;
        int lane = lane_in; asm volatile("" : "+v"(lane));
        const bf16_t* pr = WSP(bf16_t, WS_PROJ) + (size_t)row * NPROJ;
        const float* sm = WSP(float, WS_SMALL) + (size_t)row * NSM;
        bf16x8 rq[3], rk[3];
#pragma unroll
        for (int j = 0; j < 3; ++j) rq[j] = *(const bf16x8*)(pr + (lane + 64 * j) * 8);
        const bf16x8 rkv = *(const bf16x8*)(pr + 1536 + lane * 8);
#pragma unroll
        for (int j = 0; j < 3; ++j) rk[j] = *(const bf16x8*)(pr + PC_FK + (lane + 64 * j) * 8);
        const int l32 = lane & 31;
        const float x1 = sm[2 * l32], x2 = sm[2 * l32 + 1], cc = WSP(float, WS_CS)[((size_t)p * 32 + l32) * 2], sn = WSP(float, WS_CS)[((size_t)p * 32 + l32) * 2 + 1];
        f32x4 gzv[4];
#pragma unroll
        for (int j = 0; j < 4; ++j) gzv[j] = *(const f32x4*)(sm + 64 + 4 * j);
        const float zf = sm[80 + (lane < 12 ? lane : 0)] + bF[lane < 12 ? lane : 0];
        u32x4 wq[3];
        { float x[3][8]; float ss = 0.f;
#pragma unroll
            for (int j = 0; j < 3; ++j)
#pragma unroll
                for (int e = 0; e < 8; ++e) { x[j][e] = bf2f((bf16_t)rq[j][e]); ss += x[j][e] * x[j][e]; }
            const float rs = 1.0f / sqrtf(wave_sum(ss) * (1.0f / 1536.f) + EPS);
#pragma unroll
            for (int j = 0; j < 3; ++j) { wq[j].x = pk2(x[j][0] * rs, x[j][1] * rs); wq[j].y = pk2(x[j][2] * rs, x[j][3] * rs); wq[j].z = pk2(x[j][4] * rs, x[j][5] * rs); wq[j].w = pk2(x[j][6] * rs, x[j][7] * rs); } }
        u32x4 wkv;
        { float x[8]; float ss = 0.f;
#pragma unroll
            for (int e = 0; e < 8; ++e) { x[e] = bf2f((bf16_t)rkv[e]); ss += x[e] * x[e]; }
            const float rs = 1.0f / sqrtf(wave_sum(ss) * (1.0f / 512.f) + EPS);
            wkv.x = pk2(x[0] * rs, x[1] * rs); wkv.y = pk2(x[2] * rs, x[3] * rs); wkv.z = pk2(x[4] * rs, x[5] * rs); wkv.w = pk2(x[6] * rs, x[7] * rs); }
        const unsigned kpe = pk2(x1 * cc - x2 * sn, x2 * cc + x1 * sn);
        f32x4 o0, o1;
        { float acc[8];
            { const f32x4 b0 = *(const f32x4*)(bG + lane * 8), b1 = *(const f32x4*)(bG + lane * 8 + 4); acc[0] = b0.x; acc[1] = b0.y; acc[2] = b0.z; acc[3] = b0.w; acc[4] = b1.x; acc[5] = b1.y; acc[6] = b1.z; acc[7] = b1.w; }
#pragma unroll
            for (int j = 0; j < 16; ++j) { if ((j & 3) == 0) asm volatile("" ::: "memory");
                const float gz = gzv[j >> 2][j & 3]; const f32x4 w0 = *(const f32x4*)(W2 + j * 512 + lane * 8), w1 = *(const f32x4*)(W2 + j * 512 + lane * 8 + 4);
                acc[0] += gz * w0.x; acc[1] += gz * w0.y; acc[2] += gz * w0.z; acc[3] += gz * w0.w; acc[4] += gz * w1.x; acc[5] += gz * w1.y; acc[6] += gz * w1.z; acc[7] += gz * w1.w; }
            o0.x = valid ? logsig(acc[0]) * 0.0625f : 0.f; o0.y = valid ? logsig(acc[1]) * 0.0625f : 0.f; o0.z = valid ? logsig(acc[2]) * 0.0625f : 0.f; o0.w = valid ? logsig(acc[3]) * 0.0625f : 0.f;
            o1.x = valid ? logsig(acc[4]) * 0.0625f : 0.f; o1.y = valid ? logsig(acc[5]) * 0.0625f : 0.f; o1.z = valid ? logsig(acc[6]) * 0.0625f : 0.f; o1.w = valid ? logsig(acc[7]) * 0.0625f : 0.f; }
        const float lf = valid ? logsig(zf) : 0.f;
        float kn[3];
#pragma unroll
        for (int j = 0; j < 3; ++j) { float ss = 0.f;
#pragma unroll
            for (int e = 0; e < 8; ++e) { const float x = bf2f((bf16_t)rk[j][e]); ss += x * x; }
            ss += __shfl_xor(ss, 1); ss += __shfl_xor(ss, 2); ss += __shfl_xor(ss, 4); ss += __shfl_xor(ss, 8); kn[j] = ss; }
#pragma unroll
        for (int j = 0; j < 3; ++j) *(u32x4*)(WSP(bf16_t, WS_CQN) + (size_t)row * 1536 + (lane + 64 * j) * 8) = wq[j];
        *(u32x4*)(WSP(bf16_t, WS_CKVN) + (size_t)row * 512 + lane * 8) = wkv;
        if (lane < 32) *(unsigned*)(WSP(bf16_t, WS_KPE) + (size_t)row * 64 + 2 * lane) = kpe;
        *(f32x4*)(WSP(float, WS_LOGA) + (size_t)row * 512 + lane * 8) = o0; *(f32x4*)(WSP(float, WS_LOGA) + (size_t)row * 512 + lane * 8 + 4) = o1;
        if (lane < 12) WSP(float, WS_LOGF)[(size_t)row * 16 + lane] = lf;
        if ((lane & 15) == 0) {
#pragma unroll
            for (int j = 0; j < 3; ++j) WSP(float, WS_KN2)[(size_t)row * 16 + 4 * j + (lane >> 4)] = kn[j]; }
    }
}
__device__ __forceinline__ void phase_fcum(const Args& a, int gw, int lane) {
    const int G = gridDim.x; int seq;
    if (G >= 128) { if ((gw & 7) != 0 || (gw >> 3) < 96 || (gw >> 3) >= 96 + NB * 12) return; seq = (gw >> 3) - 96; }
    else { if (gw >= NB * 12) return; seq = gw; }
    const int b = seq / 12, h = seq % 12; constexpr int PER = LL / 64;
    const float* src = WSP(float, WS_LOGF) + ((size_t)b * LL + lane * PER) * 16 + h;
    float v[PER]; float s = 0.f;
#pragma unroll
    for (int i = 0; i < PER; ++i) v[i] = src[(size_t)i * 16];
#pragma unroll
    for (int i = 0; i < PER; ++i) s += v[i];
    float incl = s;
#pragma unroll
    for (int o = 1; o < 64; o <<= 1) { const float t = __shfl_up(incl, o); if (lane >= o) incl += t; }
    float run = incl - s;
    float* dst = WSP(float, WS_CF) + ((size_t)b * 12 + h) * LL + lane * PER;
#pragma unroll
    for (int i = 0; i < PER; ++i) { run += v[i]; dst[i] = run; }
#pragma unroll
    for (int t = 0; t < PER; ++t) { const int p = 64 * t + lane; v[t] = p >= NPAD ? WSP(const float, WS_KN2)[((size_t)b * LL + p) * 16 + h] : 0.f; }
    float pm = 0.f;
#pragma unroll
    for (int t = 0; t < PER; ++t) { float x = v[t];
#pragma unroll
        for (int o = 1; o < 64; o <<= 1) x = fmaxf(x, __shfl_xor(x, o));
        pm = fmaxf(pm, x); if (lane == 0) WSP(float, WS_KPM)[(size_t)seq * PER + t] = sqrtf(pm); }
}

__device__ __forceinline__ f32x4 mma16(const LAS bf16_t* A, int lda, const LAS bf16_t* Bt, int ldb, int K, int lane, f32x4 acc) {
    const LAS bf16_t* a = A + (lane & 15) * lda + 8 * (lane >> 4);
    const LAS bf16_t* b = Bt + (lane & 15) * ldb + 8 * (lane >> 4);
    for (int k0 = 0; k0 < K; k0 += 32) acc = __builtin_amdgcn_mfma_f32_16x16x32_bf16(*(const LAS bf16x8*)(a + k0), *(const LAS bf16x8*)(b + k0), acc, 0, 0, 0);
    return acc;
}

struct SkEmit { int mode; bf16_t* O; int ldo; int nbf_cols; float* F; int ldf; int rope_from; const float* cs; bf16_t* H; const unsigned long long* rss; unsigned long long* ssq; };
__device__ __forceinline__ void sk_emit(const SkEmit& e, int r, int col, float v, int lane) {
    if (e.mode == 3) { e.F[(size_t)r * e.ldf + col] = v; return; }
    if (e.mode == 2) { bf16_t* p0 = e.H + (size_t)(NPAD + r) * DM + col; const bf16_t nv = f2bf(bf2f(*p0) + v); *p0 = nv; p0[(size_t)LL * DM] = nv;
        if (e.ssq) { float s2 = bf2f(nv) * bf2f(nv); s2 += __shfl_xor(s2, 1); s2 += __shfl_xor(s2, 2); s2 += __shfl_xor(s2, 4); s2 += __shfl_xor(s2, 8);
            if ((lane & 15) == 0) { const unsigned long long q = (unsigned long long)(s2 * SS_FIX); atomicAdd(e.ssq + NPAD + r, q); atomicAdd(e.ssq + LL + NPAD + r, q); } }
        return; }
    if (e.rss) v *= 1.0f / sqrtf((float)e.rss[NPAD + r] * (SS_UNFIX / DM) + EPS);
    if (col >= e.rope_from) { const float o = __shfl_xor(v, 1); const int i = (col & 63) >> 1; const float* t = e.cs + ((size_t)(NPAD + r) * 32 + i) * 2; const float c = t[0], s = t[1];
        v = (lane & 1) ? (v * c + o * s) : (v * c - o * s); }
    if (col < e.nbf_cols) { const bf16_t w = f2bf(v); bf16_t* p0 = e.O + (size_t)(NPAD + r) * e.ldo + col; *p0 = w; p0[(size_t)LL * e.ldo] = w; }
    else { float* p0 = e.F + (size_t)(NPAD + r) * e.ldf + (col - e.nbf_cols); *p0 = v; p0[(size_t)LL * e.ldf] = v; }
}
__device__ __forceinline__ void skinny_gemm(const bf16_t* A, const bf16_t* Wt, int N, int K, int nunits, const SkEmit& e, LAS unsigned char* lds, int lane, int wave) {
    const int G = gridDim.x, rem = nunits % G;
    const int first = ((int)blockIdx.x - rem + G) % G;
    const int ql = lane & 15, quad = lane >> 4, kw = K >> 3, nsteps = kw >> 5;
    LAS f32x4* red = (LAS f32x4*)lds;
    const bf16_t* ap = A + (size_t)(NPAD + ql) * K + wave * kw + 8 * quad;
    for (int ct = first; ct < (N >> 4); ct += G) {
        const bf16_t* bp = Wt + (size_t)(16 * ct + ql) * K + wave * kw + 8 * quad;
        f32x4 acc = {0.f, 0.f, 0.f, 0.f};
        for (int s0 = 0; s0 < nsteps; s0 += 16) {
            bf16x8 af[16], bf[16];
#pragma unroll
            for (int s = 0; s < 16; ++s) if (s0 + s < nsteps) { af[s] = *(const bf16x8*)(ap + (s0 + s) * 32); bf[s] = *(const bf16x8*)(bp + (s0 + s) * 32); }
#pragma unroll
            for (int s = 0; s < 16; ++s) if (s0 + s < nsteps) acc = __builtin_amdgcn_mfma_f32_16x16x32_bf16(af[s], bf[s], acc, 0, 0, 0);
        }
        red[wave * 64 + lane] = acc;
        __syncthreads();
        if (wave == 0) {
            f32x4 s = red[lane];
#pragma unroll
            for (int w = 1; w < 8; ++w) s = s + red[w * 64 + lane];
#pragma unroll
            for (int reg = 0; reg < 4; ++reg) sk_emit(e, quad * 4 + reg, 16 * ct + ql, s[reg], lane);
        }
        __syncthreads();
    }
}

__device__ __forceinline__ void skinny_gemm_i8(const unsigned char* Aq, const unsigned char* Wq, int N, int nunits, const float* asc, const float* wsc, const SkEmit& e, LAS unsigned char* lds, int lane, int wave) {
    typedef int i32x4_t __attribute__((ext_vector_type(4)));
    const int G = gridDim.x, rem = nunits % G;
    const int first = ((int)blockIdx.x - rem + G) % G;
    const int ql = lane & 15, quad = lane >> 4;
    LAS f32x4* red = (LAS f32x4*)lds;
    if (first >= (N >> 4)) return;
    const unsigned char* ap = Aq + (size_t)(NPAD + ql) * DM + wave * (DM / 8) + 16 * quad;
    for (int ct = first; ct < (N >> 4); ct += G) {
        const unsigned char* bp = Wq + (size_t)(16 * ct + ql) * DM + wave * (DM / 8) + 16 * quad;
        i32x4_t av[8], bv[8], acc = {0, 0, 0, 0};
#pragma unroll
        for (int s = 0; s < 8; ++s) { av[s] = *(const i32x4_t*)(ap + 64 * s); bv[s] = *(const i32x4_t*)(bp + 64 * s); }
#pragma unroll
        for (int s = 0; s < 8; ++s) acc = __builtin_amdgcn_mfma_i32_16x16x64_i8(av[s], bv[s], acc, 0, 0, 0);
        f32x4 f; f[0] = (float)acc[0]; f[1] = (float)acc[1]; f[2] = (float)acc[2]; f[3] = (float)acc[3];
        red[wave * 64 + lane] = f;
        __syncthreads();
        if (wave == 0) {
            f32x4 s = red[lane];
#pragma unroll
            for (int w = 1; w < 8; ++w) s = s + red[w * 64 + lane];
            const float cs_ = wsc[16 * ct + ql];
#pragma unroll
            for (int reg = 0; reg < 4; ++reg) sk_emit(e, quad * 4 + reg, 16 * ct + ql, s[reg] * cs_ * asc[NPAD + quad * 4 + reg], lane);
        }
        __syncthreads();
    }
}

__device__ __forceinline__ void phase_gla_b1(const Args& a, LAS unsigned char* lds, int tid, int lane, int wave) {
    LAS float* LA = (LAS float*)lds;
    LAS bf16_t* AM = (LAS bf16_t*)lds;
    LAS bf16_t* QD = (LAS bf16_t*)(lds + 32768);
    LAS bf16_t* KD = (LAS bf16_t*)(lds + 32768 + 17408);
    LAS bf16_t* KST = (LAS bf16_t*)(lds + 32768 + 2 * 17408);
    LAS bf16_t* VT = (LAS bf16_t*)(lds + 32768 + 2 * 17408 + 18432);
    const f32x4 zero = {0.f, 0.f, 0.f, 0.f};
    for (int u = (int)(gridDim.x - 1 - blockIdx.x); u < GUNITS; u += gridDim.x) {
        const int b = u / (4 * GCH), h = (u / GCH) & 3, n = u % GCH; const int r0 = b * LL + 64 * n;
        f32x4 la[4]; bf16x8 qraw_[2], kraw_[2], vraw_[4];
#pragma unroll
        for (int i = 0; i < 4; ++i) { const int idx = tid + 512 * i, t = idx >> 5, k4 = (idx & 31) * 4; la[i] = *(const f32x4*)(WSP(float, WS_LOGA) + (size_t)(r0 + t) * 512 + h * 128 + k4); }
#pragma unroll
        for (int i = 0; i < 2; ++i) { const int idx = tid + 512 * i, t = idx >> 4, k0 = (idx & 15) * 8; const size_t pr = (size_t)(r0 + t) * NPROJ;
            qraw_[i] = *(const bf16x8*)(WSP(const bf16_t, WS_PROJ) + pr + PC_GQ + h * 128 + k0); kraw_[i] = *(const bf16x8*)(WSP(const bf16_t, WS_PROJ) + pr + PC_GK + h * 128 + k0); }
#pragma unroll
        for (int i = 0; i < 4; ++i) { const int idx = tid + 512 * i, t = idx >> 5, j0 = (idx & 31) * 8; vraw_[i] = *(const bf16x8*)(WSP(const bf16_t, WS_PROJ) + (size_t)(r0 + t) * NPROJ + PC_GV + h * 256 + j0); }
#pragma unroll
        for (int i = 0; i < 4; ++i) { const int idx = tid + 512 * i, t = idx >> 5, k4 = (idx & 31) * 4; *(LAS f32x4*)(LA + t * 128 + k4) = la[i]; }
        __syncthreads();
        {
            const int k = tid & 127, part = tid >> 7; float v[16]; float run = 0.f;
#pragma unroll
            for (int i = 0; i < 16; ++i) { run += LA[(16 * part + i) * 128 + k]; v[i] = run; }
#pragma unroll
            for (int i = 0; i < 16; ++i) LA[(16 * part + i) * 128 + k] = v[i];
            __syncthreads();
            float off = 0.f;
#pragma unroll
            for (int p = 0; p < 3; ++p) if (p < part) off += LA[(16 * p + 15) * 128 + k];
            __syncthreads();
#pragma unroll
            for (int i = 0; i < 16; ++i) LA[(16 * part + i) * 128 + k] = v[i] + off;
        }
        __syncthreads();
#pragma unroll
        for (int i = 0; i < 2; ++i) { const int idx = tid + 512 * i, t = idx >> 4, k0 = (idx & 15) * 8;
            const bool vf = (64 * n + t) >= NPAD;
            const bf16x8 qraw = qraw_[i], kraw = kraw_[i];
            const f32x4 b0 = *(const LAS f32x4*)(LA + t * 128 + k0), b1 = *(const LAS f32x4*)(LA + t * 128 + k0 + 4), l0 = *(const LAS f32x4*)(LA + 63 * 128 + k0), l1 = *(const LAS f32x4*)(LA + 63 * 128 + k0 + 4);
            float qd[8], kd[8];
#pragma unroll
            for (int e = 0; e < 8; ++e) { const float bb = e < 4 ? b0[e & 3] : b1[e & 3], bl = e < 4 ? l0[e & 3] : l1[e & 3];
                const float q = bf2f((bf16_t)qraw[e]) * 0.08838834764831845f, kk = vf ? bf2f((bf16_t)kraw[e]) : 0.f;
                qd[e] = q * __expf(bb); kd[e] = kk * __expf(-bb); KST[(k0 + e) * 72 + t] = f2bf(kk * __expf(bl - bb)); }
            u32x4 wq, wk; wq.x = pk2(qd[0], qd[1]); wq.y = pk2(qd[2], qd[3]); wq.z = pk2(qd[4], qd[5]); wq.w = pk2(qd[6], qd[7]); wk.x = pk2(kd[0], kd[1]); wk.y = pk2(kd[2], kd[3]); wk.z = pk2(kd[4], kd[5]); wk.w = pk2(kd[6], kd[7]);
            *(LAS u32x4*)(QD + t * 136 + k0) = wq; *(LAS u32x4*)(KD + t * 136 + k0) = wk;
            *(u32x4*)(WSP(bf16_t, WS_QDG) + (size_t)(r0 + t) * 512 + h * 128 + k0) = wq;
            if (t == 63) { f32x4 d0, d1; d0[0] = __expf(l0[0]); d0[1] = __expf(l0[1]); d0[2] = __expf(l0[2]); d0[3] = __expf(l0[3]); d1[0] = __expf(l1[0]); d1[1] = __expf(l1[1]); d1[2] = __expf(l1[2]); d1[3] = __expf(l1[3]);
                *(f32x4*)(WSP(float, WS_DEC) + (size_t)u * 128 + k0) = d0; *(f32x4*)(WSP(float, WS_DEC) + (size_t)u * 128 + k0 + 4) = d1; } }
#pragma unroll
        for (int i = 0; i < 4; ++i) { const int idx = tid + 512 * i, t = idx >> 5, j0 = (idx & 31) * 8; const bf16x8 raw = vraw_[i];
#pragma unroll
            for (int e = 0; e < 8; ++e) VT[(j0 + e) * 72 + t] = (bf16_t)raw[e]; }
        __syncthreads();
        f32x4 a2[2];
#pragma unroll
        for (int q = 0; q < 2; ++q) { const int id = wave * 2 + q, tm = id >> 2, tn = id & 3; a2[q] = mma16(QD + 16 * tm * 136, 136, KD + 16 * tn * 136, 136, 128, lane, zero); }
#pragma unroll
        for (int q = 0; q < 2; ++q) { const int id = wave * 2 + q, tm = id >> 2, tn = id & 3;
#pragma unroll
            for (int reg = 0; reg < 4; ++reg) { const int t = 16 * tm + (lane >> 4) * 4 + reg, s = 16 * tn + (lane & 15); AM[t * 72 + s] = f2bf(s <= t ? a2[q][reg] : 0.f); } }
        __syncthreads();
#pragma unroll 2
        for (int q = 0; q < 8; ++q) { const int id = wave * 8 + q, tm = id >> 4, tn = id & 15; const f32x4 o = mma16(VT + 16 * tn * 72, 72, AM + 16 * tm * 72, 72, 64, lane, zero);
            u32x2 w; w.x = pk2(o[0], o[1]); w.y = pk2(o[2], o[3]); *(u32x2*)(WSP(bf16_t, WS_OG) + (size_t)(r0 + 16 * tm + (lane & 15)) * 1024 + h * 256 + 16 * tn + (lane >> 4) * 4) = w; }
#pragma unroll 2
        for (int q = 0; q < 16; ++q) { const int id = wave * 16 + q, tm = id >> 4, tn = id & 15; const f32x4 o = mma16(KST + 16 * tm * 72, 72, VT + 16 * tn * 72, 72, 64, lane, zero);
            u32x2 w; w.x = pk2(o[0], o[1]); w.y = pk2(o[2], o[3]); *(u32x2*)(WSP(bf16_t, WS_UB) + ((size_t)u * 256 + 16 * tn + (lane & 15)) * 128 + 16 * tm + (lane >> 4) * 4) = w; }
        __syncthreads();
    }
}
__device__ __forceinline__ void phase_gla_b2(const Args& a, int tid) {
    const bf16_t* __restrict__ UB = WSP(const bf16_t, WS_UB); const float* __restrict__ DEC = WSP(const float, WS_DEC); bf16_t* __restrict__ SPT = WSP(bf16_t, WS_SPT);
    for (int gid = blockIdx.x * 512 + tid; gid < NB * 4 * 256 * 32; gid += gridDim.x * 512) {
        const int bh = gid >> 13, j = (gid >> 5) & 255, kg = gid & 31; float S0 = 0.f, S1 = 0.f, S2 = 0.f, S3 = 0.f;
#pragma unroll 22
        for (int n = 0; n < GCH; ++n) { const size_t u = (size_t)bh * GCH + n; const size_t o = (u * 256 + j) * 128 + kg * 4; const f32x4 d = *(const f32x4*)(DEC + u * 128 + kg * 4);
            const u32x2 x = *(const u32x2*)(UB + o);
            u32x2 w; w.x = pk2(S0, S1); w.y = pk2(S2, S3); *(u32x2*)(SPT + o) = w;
            S0 = S0 * d.x + __uint_as_float(x.x << 16); S1 = S1 * d.y + __uint_as_float(x.x & 0xffff0000u); S2 = S2 * d.z + __uint_as_float(x.y << 16); S3 = S3 * d.w + __uint_as_float(x.y & 0xffff0000u); }
    }
}
__device__ __forceinline__ void phase_gla_b3(const Args& a, LAS unsigned char* lds, int tid, int lane, int wave) {
    LAS bf16_t* ST = (LAS bf16_t*)lds;
    LAS bf16_t* QD = (LAS bf16_t*)(lds + 69632);
    LAS float* PS = (LAS float*)(lds + 69632 + 17408);
    const f32x4 zero = {0.f, 0.f, 0.f, 0.f};
    const int ql = lane & 15, quad = lane >> 4, tm = wave >> 1, cb0 = (wave & 1) * 128;
    for (int u = blockIdx.x; u < GUNITS; u += gridDim.x) {
        const int b = u / (4 * GCH), h = (u / GCH) & 3, n = u % GCH; const int r0 = b * LL + 64 * n;
#pragma unroll
        for (int i = 0; i < 8; ++i) { const int idx = tid + 512 * i, j = idx >> 4, ch = idx & 15; *(LAS bf16x8*)(ST + j * 136 + ch * 8) = *(const bf16x8*)(WSP(const bf16_t, WS_SPT) + ((size_t)u * 256 + j) * 128 + ch * 8); }
#pragma unroll
        for (int i = 0; i < 2; ++i) { const int idx = tid + 512 * i, t = idx >> 4, ch = idx & 15; *(LAS bf16x8*)(QD + t * 136 + ch * 8) = *(const bf16x8*)(WSP(bf16_t, WS_QDG) + (size_t)(r0 + t) * 512 + h * 128 + ch * 8); }
        const int t = 16 * tm + ql;
        u32x2 gr[8];
        { const bf16_t* gp = WSP(const bf16_t, WS_PROJ) + (size_t)(r0 + t) * NPROJ + PC_GR + h * 256 + cb0 + quad * 4;
#pragma unroll
          for (int q = 0; q < 8; ++q) gr[q] = *(const u32x2*)(gp + 16 * q); }
        __syncthreads();
        f32x4 o[8]; float ss = 0.f;
#pragma unroll
        for (int q = 0; q < 8; ++q) { o[q] = mma16(ST + (cb0 + 16 * q) * 136, 136, QD + 16 * tm * 136, 136, 128, lane, zero);
            const u32x2 g = *(const u32x2*)(WSP(const bf16_t, WS_OG) + (size_t)(r0 + t) * 1024 + h * 256 + cb0 + 16 * q + quad * 4);
            o[q][0] += __uint_as_float(g.x << 16); o[q][1] += __uint_as_float(g.x & 0xffff0000u); o[q][2] += __uint_as_float(g.y << 16); o[q][3] += __uint_as_float(g.y & 0xffff0000u);
            ss += (o[q][0] * o[q][0] + o[q][1] * o[q][1]) + (o[q][2] * o[q][2] + o[q][3] * o[q][3]); }
        ss += __shfl_xor(ss, 16); ss += __shfl_xor(ss, 32);
        if (quad == 0) PS[wave * 16 + ql] = ss;
        __syncthreads();
        { const float tot = PS[wave * 16 + ql] + PS[(wave ^ 1) * 16 + ql];
            const float rs = 1.0f / sqrtf(tot * (1.0f / 256.f) + EPS);
            bf16_t* op = WSP(bf16_t, WS_MIX) + (size_t)(r0 + t) * DM + 1536 + h * 256 + cb0 + quad * 4;
#pragma unroll
            for (int q = 0; q < 8; ++q) { float y[4];
#pragma unroll
                for (int e4 = 0; e4 < 4; ++e4) { const unsigned gw_ = e4 < 2 ? gr[q].x : gr[q].y; const float g = __uint_as_float((e4 & 1) ? (gw_ & 0xffff0000u) : (gw_ << 16));
                    y[e4] = o[q][e4] * rs * (g * __builtin_amdgcn_rcpf(1.0f + __expf(-g))); }
                u32x2 w; w.x = pk2(y[0], y[1]); w.y = pk2(y[2], y[3]); *(u32x2*)(op + 16 * q) = w; } }
        __syncthreads();
    }
}


namespace att {
typedef short s16x4 __attribute__((ext_vector_type(4)));
typedef float f32x16 __attribute__((ext_vector_type(16)));
constexpr int SHM_K = 16384, SHM_V = 16384, SHM_KP = 8192;
constexpr int OFF_V = 0, OFF_K = 2 * SHM_V, OFF_KP = OFF_K + 2 * SHM_K, OFF_BIAS = OFF_KP + 2 * SHM_KP, OFF_WS = OFF_BIAS + 512, OFF_VOTE = OFF_WS + 8 * 64 * 4, ATT_LDS = OFF_VOTE + 64;
static_assert(ATT_LDS <= RING_BYTES, "attention LDS");
constexpr float LOG2E = 1.4426950408889634f, THR2 = 8.f * 1.4426950408889634f;
#define ATT_KSWZ(row, colB) ((row) * 256 + ((colB) ^ (((row) & 15) << 4)))
#define ATT_KPSWZ(row, colB) ((row) * 128 + ((colB) ^ ((((row) >> 1) & 7) << 4)))
#define ATT_SBAR() __builtin_amdgcn_sched_barrier(0)
__device__ __forceinline__ int v_st(int k, int c) { const int kk = (k & ~0xC) | ((k & 4) << 1) | ((k & 8) >> 1); return ((kk >> 3) * 4 + (c >> 5)) * 512 + ((kk & 7) * 32 + (c & 31)) * 2; }
__device__ __forceinline__ int v_rd_base(int lane) { return ((lane & 3) << 3) | (((lane >> 2) & 3) << 6) | (((lane >> 4) & 1) << 5) | (((lane >> 5) & 1) << 8); }
constexpr int v_rd_off(int d0, int ks, int half) { return d0 * 512 + ks * 4096 + half * 2048; }
__device__ __forceinline__ int crow(int r, int hi) { return (r & 3) + 8 * (r >> 2) + 4 * hi; }
__device__ __forceinline__ unsigned cvtpk(float lo, float hi) { unsigned r; asm volatile("v_cvt_pk_bf16_f32 %0, %1, %2" : "=v"(r) : "v"(lo), "v"(hi)); return r; }

template <int KB, int TYPE>
__device__ __forceinline__ void qkt(f32x16& p0, f32x16& p1, const LAS char* lds, int r32, int hi, const bf16x8* qr, const bf16x8* qpe) {
    p0 = f32x16{}; p1 = f32x16{};
    int ko[4];
#pragma unroll
    for (int dd = 0; dd < 4; ++dd) ko[dd] = ATT_KSWZ(r32, (dd * 16 + hi * 8) * 2);
    int kx = 128; asm volatile("" : "+v"(kx));
    constexpr int NS = TYPE == 0 ? 12 : 8;
    bf16x8 c0, c1, n0, n1;
#define ATT_KRD(s_, x0, x1) do { if ((s_) < 8) { const LAS char* ka = lds + OFF_K + KB * SHM_K + ((s_) < 4 ? ko[(s_) & 3] : (ko[(s_) & 3] ^ kx)); \
            x0 = *reinterpret_cast<const LAS bf16x8*>(ka); x1 = *reinterpret_cast<const LAS bf16x8*>(ka + 32 * 256); } \
        else { const LAS char* ka = lds + OFF_KP + KB * SHM_KP + ATT_KPSWZ(r32, ((((s_) - 8) & 3) * 16 + hi * 8) * 2); \
            x0 = *reinterpret_cast<const LAS bf16x8*>(ka); x1 = *reinterpret_cast<const LAS bf16x8*>(ka + 32 * 128); } } while (0)
    ATT_KRD(0, c0, c1);
#pragma unroll
    for (int s = 0; s < NS; ++s) {
        if (s + 1 < NS) ATT_KRD(s + 1, n0, n1);
        ATT_SBAR();
        const bf16x8 qq = s < 8 ? qr[s & 7] : qpe[(s - 8) & 3];
        p0 = __builtin_amdgcn_mfma_f32_32x32x16_bf16(c0, qq, p0, 0, 0, 0);
        p1 = __builtin_amdgcn_mfma_f32_32x32x16_bf16(c1, qq, p1, 0, 0, 0);
        ATT_SBAR();
        c0 = n0; c1 = n1;
    }
#undef ATT_KRD
}
template <int VB>
__device__ __forceinline__ void pv_tile(f32x16* o, int vb0, bf16x8 pa0, bf16x8 pa1, bf16x8 pa2, bf16x8 pa3) {
#define ATT_TRRD(dst, off) asm volatile("ds_read_b64_tr_b16 %0, %1 offset:%2" : "=&v"(dst) : "v"(vb0), "i"(off) : "memory")
    s16x4 L0[4], H0[4], L1[4], H1[4];
#define ATT_PV_RD(d0, L, H) do { constexpr int b_ = OFF_V + VB * SHM_V + v_rd_off(d0, 0, 0); \
        ATT_TRRD(L[0], b_); ATT_TRRD(H[0], b_ + 2048); ATT_TRRD(L[1], b_ + 4096); ATT_TRRD(H[1], b_ + 6144); ATT_TRRD(L[2], b_ + 8192); ATT_TRRD(H[2], b_ + 10240); ATT_TRRD(L[3], b_ + 12288); ATT_TRRD(H[3], b_ + 14336); } while (0)
#define ATT_PV_MM(d0, L, H) do { \
        o[d0] = __builtin_amdgcn_mfma_f32_32x32x16_bf16(pa0, (bf16x8){L[0][0], L[0][1], L[0][2], L[0][3], H[0][0], H[0][1], H[0][2], H[0][3]}, o[d0], 0, 0, 0);   \
        o[d0] = __builtin_amdgcn_mfma_f32_32x32x16_bf16(pa1, (bf16x8){L[1][0], L[1][1], L[1][2], L[1][3], H[1][0], H[1][1], H[1][2], H[1][3]}, o[d0], 0, 0, 0);   \
        o[d0] = __builtin_amdgcn_mfma_f32_32x32x16_bf16(pa2, (bf16x8){L[2][0], L[2][1], L[2][2], L[2][3], H[2][0], H[2][1], H[2][2], H[2][3]}, o[d0], 0, 0, 0);   \
        o[d0] = __builtin_amdgcn_mfma_f32_32x32x16_bf16(pa3, (bf16x8){L[3][0], L[3][1], L[3][2], L[3][3], H[3][0], H[3][1], H[3][2], H[3][3]}, o[d0], 0, 0, 0); } while (0)
    ATT_PV_RD(0, L0, H0);
    ATT_PV_RD(1, L1, H1); asm volatile("s_waitcnt lgkmcnt(8)" ::: "memory"); ATT_SBAR(); ATT_PV_MM(0, L0, H0); ATT_SBAR();
    ATT_PV_RD(2, L0, H0); asm volatile("s_waitcnt lgkmcnt(8)" ::: "memory"); ATT_SBAR(); ATT_PV_MM(1, L1, H1); ATT_SBAR();
    ATT_PV_RD(3, L1, H1); asm volatile("s_waitcnt lgkmcnt(8)" ::: "memory"); ATT_SBAR(); ATT_PV_MM(2, L0, H0); ATT_SBAR();
    asm volatile("s_waitcnt lgkmcnt(0)" ::: "memory"); ATT_SBAR(); ATT_PV_MM(3, L1, H1);
#undef ATT_PV_MM
#undef ATT_PV_RD
#undef ATT_TRRD
}
template <int TYPE>
__device__ __forceinline__ void softmax_tile(f32x16& p0, f32x16& p1, float& m_reg, float& l_reg, float& alpha, bf16x8& pa0, bf16x8& pa1, bf16x8& pa2, bf16x8& pa3,
                                             const LAS float* bias, int hi, bool need_mask, int lo, int dq) {
    constexpr float C2 = (TYPE == 0 ? 0.07216878364870322f : 0.08838834764831845f) * LOG2E;
    if (TYPE == 1) {
#pragma unroll
        for (int g = 0; g < 4; ++g) { const f32x4 b0 = *(const LAS f32x4*)(bias + 8 * g + 4 * hi), b1 = *(const LAS f32x4*)(bias + 32 + 8 * g + 4 * hi);
#pragma unroll
            for (int i = 0; i < 4; ++i) { p0[4 * g + i] = fmaf(p0[4 * g + i], C2, b0[i]); p1[4 * g + i] = fmaf(p1[4 * g + i], C2, b1[i]); } }
    } else {
#pragma unroll
        for (int r = 0; r < 16; ++r) { p0[r] *= C2; p1[r] *= C2; }
    }
    if (need_mask) {
        const float NEG = -__builtin_inff(); const int loh = lo - 4 * hi, dqh = dq - 4 * hi;
#pragma unroll
        for (int r = 0; r < 16; ++r) { const int c = (r & 3) + 8 * (r >> 2);
            if (c < loh || c > dqh) p0[r] = NEG;
            if (c + 32 < loh || c + 32 > dqh) p1[r] = NEG; }
    }
    float pmax = p0[0];
#pragma unroll
    for (int r = 1; r < 16; ++r) pmax = fmaxf(pmax, p0[r]);
#pragma unroll
    for (int r = 0; r < 16; ++r) pmax = fmaxf(pmax, p1[r]);
    { auto rr = __builtin_amdgcn_permlane32_swap(__float_as_uint(pmax), __float_as_uint(pmax), false, false);
      pmax = fmaxf(__uint_as_float(rr[0]), __uint_as_float(rr[1])); }
    float mn;
    if (__builtin_expect(__all(pmax - m_reg <= THR2), 1)) { mn = m_reg; alpha = 1.f; }
    else { mn = fmaxf(m_reg, pmax); alpha = __builtin_amdgcn_exp2f(m_reg - mn); m_reg = mn; }
#pragma unroll
    for (int r = 0; r < 16; ++r) { p0[r] = __builtin_amdgcn_exp2f(p0[r] - mn); p1[r] = __builtin_amdgcn_exp2f(p1[r] - mn); }
    float ps = 0.f;
#pragma unroll
    for (int r = 0; r < 16; ++r) ps += p0[r];
#pragma unroll
    for (int r = 0; r < 16; ++r) ps += p1[r];
    { auto rr = __builtin_amdgcn_permlane32_swap(__float_as_uint(ps), __float_as_uint(ps), false, false);
      ps = __uint_as_float(rr[0]) + __uint_as_float(rr[1]); }
    l_reg = l_reg * alpha + ps;
#define ATT_PK4(P, B_, OUT) do { unsigned a0 = cvtpk(P[B_+0], P[B_+1]), a1 = cvtpk(P[B_+2], P[B_+3]);                          \
        unsigned b0 = cvtpk(P[B_+4], P[B_+5]), b1 = cvtpk(P[B_+6], P[B_+7]);                                             \
        auto r0 = __builtin_amdgcn_permlane32_swap(a0, b0, false, false); auto r1 = __builtin_amdgcn_permlane32_swap(a1, b1, false, false); \
        u32x4 w = {r0[0], r1[0], r0[1], r1[1]}; OUT = *reinterpret_cast<bf16x8*>(&w); } while (0)
    ATT_PK4(p0, 0, pa0); ATT_PK4(p0, 8, pa1); ATT_PK4(p1, 0, pa2); ATT_PK4(p1, 8, pa3);
#undef ATT_PK4
}

template <int TYPE>
__device__ __forceinline__ void attn_block(const Args& a, LAS char* lds, int b, int h, int q0, int row_store_end, int tid, int lane, int wid) {
    const int r32 = lane & 31, hi = lane >> 5;
    const size_t rb = (size_t)b * LL;
    constexpr int QS = TYPE == 0 ? NQ : NPROJ, KS = TYPE == 0 ? NKV : NPROJ;
    const bf16_t* Qn = TYPE == 0 ? WSP(const bf16_t, WS_QM) + h * 128 : WSP(const bf16_t, WS_PROJ) + PC_FQ + h * 128;
    const bf16_t* Kn = TYPE == 0 ? WSP(const bf16_t, WS_KVM) + h * 128 : WSP(const bf16_t, WS_PROJ) + PC_FK + h * 128;
    const bf16_t* Vv = TYPE == 0 ? WSP(const bf16_t, WS_KVM) + 1536 + h * 128 : WSP(const bf16_t, WS_PROJ) + PC_FV + h * 128;
    const bf16_t* Kp = WSP(const bf16_t, WS_KPE);
    const float* cf = WSP(const float, WS_CF) + ((size_t)b * 12 + h) * LL;
    const int qrow = q0 + wid * 32 + r32, qlo = q0 + wid * 32;
    bf16x8 qr[8], qpe[4];
#pragma unroll
    for (int d0 = 0; d0 < 8; ++d0) qr[d0] = *(const bf16x8*)(Qn + (rb + qrow) * QS + d0 * 16 + hi * 8);
#pragma unroll
    for (int d0 = 0; d0 < 4; ++d0) qpe[d0] = TYPE == 0 ? *(const bf16x8*)(WSP(const bf16_t, WS_QM) + (rb + qrow) * NQ + 1536 + h * 64 + d0 * 16 + hi * 8) : qr[0];
    const int NT = (q0 + 256) / 64 - 1;
    const int sr = tid >> 4, sc = (tid & 15) * 8, kws = ATT_KSWZ(sr, sc * 2), vst0 = v_st(sr, sc), vst1 = v_st(32 + sr, sc);
    const int kpkey = tid >> 3, kpch = tid & 7, kpws = ATT_KPSWZ(kpkey, kpch * 16);
    const int vb0 = (int)(unsigned)(uintptr_t)(lds + OFF_V) + v_rd_base(lane);
    LAS float* wsl = (LAS float*)(lds + OFF_WS) + wid * 64; LAS float* li_l = wsl; LAS float* al_l = wsl + 32;
    LAS unsigned* votes = (LAS unsigned*)(lds + OFF_VOTE);
    bf16x8 sk0, sk1, sv0, sv1, skp; float sbias = 0.f;
    const unsigned koff = (unsigned)(sr * KS + sc) * 2u, kpoff = (unsigned)(kpkey * 64 + kpch * 8) * 2u, boff = (unsigned)(tid & 63) * 4u;
    float qn = 0.f;
    if (TYPE == 1) {
#pragma unroll
        for (int d0 = 0; d0 < 8; ++d0)
#pragma unroll
            for (int e = 0; e < 8; ++e) { const float x = bf2f((bf16_t)qr[d0][e]); qn += x * x; }
        { auto rr = __builtin_amdgcn_permlane32_swap(__float_as_uint(qn), __float_as_uint(qn), false, false); qn = __uint_as_float(rr[0]) + __uint_as_float(rr[1]); }
        qn = sqrtf(qn) * (0.08838834764831845f * LOG2E * 1.001f);
    }
    const float* kpm = WSP(const float, WS_KPM) + ((size_t)b * 12 + h) * (LL / 64);
#define ATT_LOADT(kb) do { const char* kt_ = (const char*)(Kn + (rb + (kb)) * KS); const char* vt_ = (const char*)(Vv + (rb + (kb)) * KS); \
        sk0 = *(const bf16x8*)(kt_ + koff); sk1 = *(const bf16x8*)(kt_ + (size_t)32 * KS * 2 + koff); \
        sv0 = *(const bf16x8*)(vt_ + koff); sv1 = *(const bf16x8*)(vt_ + (size_t)32 * KS * 2 + koff); \
        if (TYPE == 0) skp = *(const bf16x8*)((const char*)(Kp + (rb + (kb)) * 64) + kpoff); \
        if (TYPE == 1 && tid < 64) sbias = *(const float*)((const char*)(cf + (kb)) + boff); } while (0)
#define ATT_WRITET(bf) do { *(LAS bf16x8*)(lds + OFF_K + (bf) * SHM_K + kws) = sk0; *(LAS bf16x8*)(lds + OFF_K + (bf) * SHM_K + kws + 32 * 256) = sk1; \
        *(LAS bf16x8*)(lds + OFF_V + (bf) * SHM_V + vst0) = sv0; *(LAS bf16x8*)(lds + OFF_V + (bf) * SHM_V + vst1) = sv1; \
        if (TYPE == 0) *(LAS bf16x8*)(lds + OFF_KP + (bf) * SHM_KP + kpws) = skp; \
        if (TYPE == 1 && tid < 64) *(LAS float*)(lds + OFF_BIAS + (bf) * 256 + tid * 4) = -sbias * LOG2E; } while (0)
    float m_reg = -1e30f, l_reg = 0.f, alpha = 1.f; f32x16 o[4] = {};
    f32x16 p0, p1; bf16x8 pa0, pa1, pa2, pa3;
    bool stop = false;
    __syncthreads();
    ATT_LOADT(64 * NT); ATT_WRITET(0);
    __syncthreads();
#define ATT_STEP(t, BUF) do { const int kb_ = 64 * (NT - (t)); const bool more_ = (t) + 1 < NT; \
        if (more_) ATT_LOADT(kb_ - 64); \
        ATT_SBAR(); __builtin_amdgcn_s_setprio(1); qkt<BUF, TYPE>(p0, p1, lds, r32, hi, qr, qpe); __builtin_amdgcn_s_setprio(0); \
        softmax_tile<TYPE>(p0, p1, m_reg, l_reg, alpha, pa0, pa1, pa2, pa3, (const LAS float*)(lds + OFF_BIAS + (BUF) * 256), hi, kb_ == 64 || kb_ + 63 > qlo, NPAD - kb_, qrow - kb_); \
        if (TYPE == 1 && more_) { const float bnd_ = qn * kpm[kb_ / 64 - 1] - cf[kb_ - 1] * LOG2E; const bool ok_ = (bnd_ - m_reg < -170.f) || (qrow < NPAD); \
            const bool all_ = __all(ok_); if (lane == 0) votes[((t) & 1) * 8 + wid] = all_ ? 1u : 0u; } \
        if (__any(alpha < 1.f)) { if (hi == 0) al_l[r32] = alpha; asm volatile("s_waitcnt lgkmcnt(0)" ::: "memory"); \
            _Pragma("unroll") for (int d_ = 0; d_ < 4; ++d_) _Pragma("unroll") for (int r = 0; r < 16; ++r) o[d_][r] *= al_l[crow(r, hi)]; } \
        ATT_SBAR(); __builtin_amdgcn_s_setprio(1); pv_tile<BUF>(o, vb0, pa0, pa1, pa2, pa3); __builtin_amdgcn_s_setprio(0); \
        if (more_) ATT_WRITET((BUF) ^ 1); \
        __syncthreads(); \
        if (TYPE == 1 && more_) { const u32x4 va_ = *(const LAS u32x4*)(votes + ((t) & 1) * 8), vb_ = *(const LAS u32x4*)(votes + ((t) & 1) * 8 + 4); \
            stop = (va_[0] & va_[1] & va_[2] & va_[3] & vb_[0] & vb_[1] & vb_[2] & vb_[3]) != 0u; } } while (0)
#define ATT_SKIP(t, BUF) do { const int kb_ = 64 * (NT - (t)); const bool more_ = (t) + 1 < NT; \
        if (more_) ATT_LOADT(kb_ - 64); \
        if (TYPE == 1 && more_ && lane == 0) votes[((t) & 1) * 8 + wid] = 0u;        \
        if (more_) ATT_WRITET((BUF) ^ 1); \
        __syncthreads(); } while (0)
    int t = 0;
    { int ts = NT - (qlo + 31) / 64; ts = (ts < 0 ? 0 : ts > NT ? NT : ts) & ~1;
      for (; t < ts; t += 2) { ATT_SKIP(t, 0); ATT_SKIP(t + 1, 1); } }
#undef ATT_SKIP
    for (; t + 1 < NT && !stop; t += 2) { ATT_STEP(t, 0); if (!stop) ATT_STEP(t + 1, 1); }
    if (!stop && t < NT) ATT_STEP(t, 0);
    if (hi == 0) li_l[r32] = l_reg;
    asm volatile("s_waitcnt lgkmcnt(0)" ::: "memory");
    if (qlo < row_store_end) {
        int hoff = 4 * hi; asm volatile("" : "+v"(hoff));
        bf16_t* Ow = WSP(bf16_t, WS_MIX) + (rb + qlo) * DM + (TYPE == 0 ? 0 : 2560) + h * 128 + r32;
#pragma unroll
        for (int r = 0; r < 16; ++r) { const int orow = (r & 3) + 8 * (r >> 2) + hoff; const float lv = li_l[orow]; const float inv = lv > 0.f ? __builtin_amdgcn_rcpf(lv) : 0.f;
            const float x0 = o[0][r] * inv, x1 = o[1][r] * inv, x2 = o[2][r] * inv, x3 = o[3][r] * inv;
            float ss = (x0 * x0 + x1 * x1) + (x2 * x2 + x3 * x3);
            ss += __shfl_xor(ss, 1); ss += __shfl_xor(ss, 2); ss += __shfl_xor(ss, 4); ss += __shfl_xor(ss, 8); ss += __shfl_xor(ss, 16);
            const float rs = 1.0f / sqrtf(ss * (1.0f / 128.f) + EPS);
            bf16_t* op = Ow + (size_t)orow * DM;
            op[0] = f2bf(x0 * rs); op[32] = f2bf(x1 * rs); op[64] = f2bf(x2 * rs); op[96] = f2bf(x3 * rs); }
    }
#undef ATT_LOADT
#undef ATT_WRITET
#undef ATT_STEP
}
}
constexpr int ATT_SCHED_LEN = 4;
__device__ const unsigned short ATT_SCHED[256][4] = {
{15,696,65535,65535},
{32,713,65535,65535},
{49,730,65535,65535},
{66,747,65535,65535},
{83,764,65535,65535},
{100,781,65535,65535},
{117,798,65535,65535},
{134,815,65535,65535},
{151,65535,65535,65535},
{168,65535,65535,65535},
{185,65535,65535,65535},
{202,65535,65535,65535},
{219,65535,65535,65535},
{236,65535,65535,65535},
{253,65535,65535,65535},
{270,65535,65535,65535},
{287,65535,65535,65535},
{304,65535,65535,65535},
{321,65535,65535,65535},
{338,65535,65535,65535},
{355,65535,65535,65535},
{372,65535,65535,65535},
{389,65535,65535,65535},
{406,65535,65535,65535},
{14,272,65535,65535},
{31,289,65535,65535},
{48,306,65535,65535},
{65,323,65535,65535},
{82,340,65535,65535},
{99,357,65535,65535},
{116,374,65535,65535},
{133,391,65535,65535},
{150,408,65535,65535},
{167,425,65535,65535},
{184,442,65535,65535},
{201,459,65535,65535},
{218,476,65535,65535},
{235,493,65535,65535},
{252,510,65535,65535},
{269,527,65535,65535},
{286,544,65535,65535},
{303,561,65535,65535},
{320,578,65535,65535},
{337,595,65535,65535},
{354,612,65535,65535},
{371,629,65535,65535},
{388,646,65535,65535},
{405,663,65535,65535},
{13,682,65535,65535},
{30,699,65535,65535},
{47,716,65535,65535},
{64,733,65535,65535},
{81,750,65535,65535},
{98,767,65535,65535},
{115,784,65535,65535},
{132,801,65535,65535},
{149,683,65535,65535},
{166,700,65535,65535},
{183,717,65535,65535},
{200,734,65535,65535},
{217,751,65535,65535},
{234,768,65535,65535},
{251,785,65535,65535},
{268,802,65535,65535},
{285,684,65535,65535},
{302,701,65535,65535},
{319,718,65535,65535},
{336,735,65535,65535},
{353,752,65535,65535},
{370,769,65535,65535},
{387,786,65535,65535},
{404,803,65535,65535},
{12,551,680,65535},
{29,568,697,65535},
{46,585,714,65535},
{63,602,731,65535},
{80,619,748,65535},
{97,636,765,65535},
{114,653,782,65535},
{131,670,799,65535},
{148,552,16,65535},
{165,569,33,65535},
{182,586,50,65535},
{199,603,67,65535},
{216,620,84,65535},
{233,637,101,65535},
{250,654,118,65535},
{267,671,135,65535},
{284,553,152,65535},
{301,570,169,65535},
{318,587,186,65535},
{335,604,203,65535},
{352,621,220,65535},
{369,638,237,65535},
{386,655,254,65535},
{403,672,271,65535},
{11,417,685,65535},
{28,434,702,65535},
{45,451,719,65535},
{62,468,736,65535},
{79,485,753,65535},
{96,502,770,65535},
{113,519,787,65535},
{130,536,804,65535},
{147,418,686,65535},
{164,435,703,65535},
{181,452,720,65535},
{198,469,737,65535},
{215,486,754,65535},
{232,503,771,65535},
{249,520,788,65535},
{266,537,805,65535},
{283,419,687,65535},
{300,436,704,65535},
{317,453,721,65535},
{334,470,738,65535},
{351,487,755,65535},
{368,504,772,65535},
{385,521,789,65535},
{402,538,806,65535},
{10,410,554,288},
{27,427,571,305},
{44,444,588,322},
{61,461,605,339},
{78,478,622,356},
{95,495,639,373},
{112,512,656,390},
{129,529,673,407},
{146,411,555,424},
{163,428,572,441},
{180,445,589,458},
{197,462,606,475},
{214,479,623,492},
{231,496,640,509},
{248,513,657,526},
{265,530,674,543},
{282,412,556,560},
{299,429,573,577},
{316,446,590,594},
{333,463,607,611},
{350,480,624,628},
{367,497,641,645},
{384,514,658,662},
{401,531,675,679},
{9,137,421,689},
{26,154,438,706},
{43,171,455,723},
{60,188,472,740},
{77,205,489,757},
{94,222,506,774},
{111,239,523,791},
{128,256,540,808},
{145,273,422,690},
{162,290,439,707},
{179,307,456,724},
{196,324,473,741},
{213,341,490,758},
{230,358,507,775},
{247,375,524,792},
{264,392,541,809},
{281,409,420,688},
{298,426,437,705},
{315,443,454,722},
{332,460,471,739},
{349,477,488,756},
{366,494,505,773},
{383,511,522,790},
{400,528,539,807},
{8,138,423,691},
{25,155,440,708},
{42,172,457,725},
{59,189,474,742},
{76,206,491,759},
{93,223,508,776},
{110,240,525,793},
{127,257,542,810},
{144,274,545,692},
{161,291,562,709},
{178,308,579,726},
{195,325,596,743},
{212,342,613,760},
{229,359,630,777},
{246,376,647,794},
{263,393,664,811},
{280,1,413,557},
{297,18,430,574},
{314,35,447,591},
{331,52,464,608},
{348,69,481,625},
{365,86,498,642},
{382,103,515,659},
{399,120,532,676},
{7,139,546,693},
{24,156,563,710},
{41,173,580,727},
{58,190,597,744},
{75,207,614,761},
{92,224,631,778},
{109,241,648,795},
{126,258,665,812},
{143,275,547,694},
{160,292,564,711},
{177,309,581,728},
{194,326,598,745},
{211,343,615,762},
{228,360,632,779},
{245,377,649,796},
{262,394,666,813},
{279,2,414,558},
{296,19,431,575},
{313,36,448,592},
{330,53,465,609},
{347,70,482,626},
{364,87,499,643},
{381,104,516,660},
{398,121,533,677},
{6,140,548,695},
{23,157,565,712},
{40,174,582,729},
{57,191,599,746},
{74,208,616,763},
{91,225,633,780},
{108,242,650,797},
{125,259,667,814},
{142,276,549,0},
{159,293,566,17},
{176,310,583,34},
{193,327,600,51},
{210,344,617,68},
{227,361,634,85},
{244,378,651,102},
{261,395,668,119},
{278,3,415,559},
{295,20,432,576},
{312,37,449,593},
{329,54,466,610},
{346,71,483,627},
{363,88,500,644},
{380,105,517,661},
{397,122,534,678},
{5,277,550,136},
{22,294,567,153},
{39,311,584,170},
{56,328,601,187},
{73,345,618,204},
{90,362,635,221},
{107,379,652,238},
{124,396,669,255},
{141,4,416,681},
{158,21,433,698},
{175,38,450,715},
{192,55,467,732},
{209,72,484,749},
{226,89,501,766},
{243,106,518,783},
{260,123,535,800}
};
constexpr int ATT_UNITS2 = 2 * 2 * 12 * 17;
__device__ __forceinline__ void att_unit(const Args& a, LAS char* lds, int uid, int tid, int lane, int wid) {
    const int blk = uid % 17, rest = uid / 17, h = rest % 12, tb = rest / 12, b = tb & 1, ty = tb >> 1;
    const int q0 = blk == 16 ? 0 : 128 + 256 * blk, rse = blk == 16 ? 128 : (1 << 30);
    if (ty == 0) att::attn_block<0>(a, lds, b, h, q0, rse, tid, lane, wid); else att::attn_block<1>(a, lds, b, h, q0, rse, tid, lane, wid);
}
__device__ __forceinline__ void phase_attn2(const Args& a, LAS unsigned char* lds_, int tid, int lane, int wid) {
    LAS char* lds = (LAS char*)lds_;
    const bool tab = gridDim.x == 256;
    for (int k = 0; ; ++k) {
        int uid;
        if (tab) { if (k >= ATT_SCHED_LEN) break; uid = ATT_SCHED[blockIdx.x][k]; if (uid == 0xFFFF) break; }
        else { uid = blockIdx.x + k * gridDim.x; if (uid >= ATT_UNITS2) break; }
        att_unit(a, lds, uid, tid, lane, wid);
    }
}

__device__ __forceinline__ void phase_mixnorm(const Args& a, int gw, int NGW, int lane) {
    for (int row = gw; row < R; row += NGW) {
        const f32x4* src = (const f32x4*)(WSP(float, WS_OG) + (size_t)row * DM); u32x2* dst = (u32x2*)(WSP(bf16_t, WS_MIX) + (size_t)row * DM);
#pragma unroll
        for (int j = 0; j < 16; ++j) {
            f32x4 v = src[64 * j + lane];
            float ss = (v.x * v.x + v.y * v.y) + (v.z * v.z + v.w * v.w);
            ss += __shfl_xor(ss, 1); ss += __shfl_xor(ss, 2); ss += __shfl_xor(ss, 4); ss += __shfl_xor(ss, 8); ss += __shfl_xor(ss, 16);
            float rs;
            if (j >= 6 && j < 10) { ss += __shfl_xor(ss, 32); rs = 1.0f / sqrtf(ss * (1.0f / 256.f) + EPS);
                const u32x2 g = *(const u32x2*)(WSP(bf16_t, WS_PROJ) + (size_t)row * NPROJ + PC_GR + (j - 6) * 256 + 4 * lane);
                const float g0 = __uint_as_float(g.x << 16), g1 = __uint_as_float(g.x & 0xffff0000u), g2 = __uint_as_float(g.y << 16), g3 = __uint_as_float(g.y & 0xffff0000u);
                v.x *= rs * (g0 / (1.0f + __expf(-g0))); v.y *= rs * (g1 / (1.0f + __expf(-g1))); v.z *= rs * (g2 / (1.0f + __expf(-g2))); v.w *= rs * (g3 / (1.0f + __expf(-g3)));
            } else { rs = 1.0f / sqrtf(ss * (1.0f / 128.f) + EPS); v = v * rs; }
            u32x2 w; w.x = pk2(v.x, v.y); w.y = pk2(v.z, v.w); dst[64 * j + lane] = w;
        }
    }
}

__device__ __forceinline__ void phase_convfix(const Args& a, int layer, int tid) {
    const float* cw = a.in[17] + (size_t)layer * 3 * NUP; const float* cb = a.in[18] + (size_t)layer * NUP;
    const float* UM = WSP(const float, WS_UM); const float* EDGE = WSP(const float, WS_EDGE);
    constexpr int NCH = DFF / 8, NROWS = 16 + 64;
    for (int item = blockIdx.x * 512 + tid; item < NROWS * NCH; item += gridDim.x * 512) {
        const int rr = item / NCH, chk = item - rr * NCH, ch0 = chk * 8, gcol = (ch0 >> 7) * 256 + (ch0 & 127);
        const float* X; const float* P1; const float* P2; int orow0, orow1;
        if (rr < 16) { X = UM + (size_t)rr * NUP; P1 = rr >= 1 ? UM + (size_t)(rr - 1) * NUP : nullptr; P2 = rr >= 2 ? UM + (size_t)(rr - 2) * NUP : nullptr; orow0 = NPAD + rr; orow1 = LL + NPAD + rr; }
        else { const int k = rr - 16, pm = k >> 1, j = k & 1; const bool i0 = (pm & 15) == 0; const float* E = EDGE + (size_t)pm * 4 * NUP;
            const float* prev3 = i0 ? UM + (size_t)15 * NUP : E - (size_t)1 * NUP; const float* prev2 = i0 ? UM + (size_t)14 * NUP : E - (size_t)2 * NUP;
            if (j == 0) { X = E; P1 = prev3; P2 = prev2; } else { X = E + NUP; P1 = E; P2 = prev3; }
            orow0 = pg8::prow(pm) + j; orow1 = -1; }
        float o[8];
#pragma unroll
        for (int h = 0; h < 2; ++h) {
            const int cg_ = gcol + 4 * h, ch = ch0 + 4 * h;
            const f32x4 xg = *(const f32x4*)(X + cg_), xv = *(const f32x4*)(X + cg_ + 128);
            const f32x4 z = {0.f, 0.f, 0.f, 0.f};
            const f32x4 p1g = P1 ? *(const f32x4*)(P1 + cg_) : z, p1v = P1 ? *(const f32x4*)(P1 + cg_ + 128) : z, p2g = P2 ? *(const f32x4*)(P2 + cg_) : z, p2v = P2 ? *(const f32x4*)(P2 + cg_ + 128) : z;
            const f32x4 wg0 = *(const f32x4*)(cw + ch), wg1 = *(const f32x4*)(cw + NUP + ch), wg2 = *(const f32x4*)(cw + 2 * NUP + ch), bg = *(const f32x4*)(cb + ch);
            const f32x4 wv0 = *(const f32x4*)(cw + DFF + ch), wv1 = *(const f32x4*)(cw + NUP + DFF + ch), wv2 = *(const f32x4*)(cw + 2 * NUP + DFF + ch), bv = *(const f32x4*)(cb + DFF + ch);
#pragma unroll
            for (int e = 0; e < 4; ++e) { const float cg = bg[e] + wg0[e] * p2g[e] + wg1[e] * p1g[e] + wg2[e] * xg[e], cv = bv[e] + wv0[e] * p2v[e] + wv1[e] * p1v[e] + wv2[e] * xv[e];
                o[4 * h + e] = cg * __builtin_amdgcn_rcpf(1.0f + __expf(-cg)) * cv; }
        }
        u32x4 w; w.x = pk2(o[0], o[1]); w.y = pk2(o[2], o[3]); w.z = pk2(o[4], o[5]); w.w = pk2(o[6], o[7]);
        *(u32x4*)(WSP(bf16_t, WS_ACT) + (size_t)orow0 * DFF + ch0) = w;
        if (orow1 >= 0) *(u32x4*)(WSP(bf16_t, WS_ACT) + (size_t)orow1 * DFF + ch0) = w;
    }
}

constexpr int NPH_LAYER = 12, NPHASES = 1 + 2 * NPH_LAYER;
#define IN(k) (lo <= (k) && (k) < hi)
#define SEAM(k) do { if (IN(k) && IN((k) + 1)) xcd_barrier(bar); } while (0)
#define SEAM2(k, kn) do { if (IN(k) && IN(kn)) xcd_barrier(bar); } while (0)
#define TIDX() int lane_x; asm volatile("v_mbcnt_lo_u32_b32 %0, -1, 0\n\tv_mbcnt_hi_u32_b32 %0, -1, %0" : "=v"(lane_x)); const int lane = lane_x, wave = wave_s, tid = wave * 64 + lane; const int gw = blockIdx.x * 8 + wave, NGW = gridDim.x * 8; (void)gw; (void)NGW; (void)lane
template <int LAYER>
__device__ __forceinline__ void layer_phases(const Args& a, const XcdBarrier& bar, LAS unsigned char* lds, int lo, int hi, const int wave_s) {
    constexpr int pb = 1 + NPH_LAYER * LAYER;
    constexpr size_t WB = WS_W + (size_t)LAYER * SZ_WLAYER;
    if (IN(pb + 0)) {
        pg8::Gemm g{WSP(bf16_t, WS_H), WSP(const bf16_t, WB + OFF_WIN), R, NIN, DM};   pg8::StaticOrder S; S.init(NB * SEQ, NIN, (int)gridDim.x, (int)blockIdx.x);
        pg8::EpiBf E{WSP(bf16_t, WS_PROJ), NPROJ, 38, 1 << 30, WSP(float, WS_SMALL), NSM, WSP(float, WS_CS), (const unsigned long long*)(a.ws + (LAYER == 0 ? WS_SS0 : WS_SS1))};
        pg8::gemm_phase<pg8::EpiBf, pg8::StaticOrder, true, true>(lds, g, S, E, wave_s);
        __syncthreads();
        { TIDX(); (void)tid; const SkEmit e{0, WSP(bf16_t, WS_PROJ), NPROJ, NPROJ, WSP(float, WS_SMALL), NSM, 1 << 30, WSP(float, WS_CS), nullptr, (const unsigned long long*)(a.ws + (LAYER == 0 ? WS_SS0 : WS_SS1)), nullptr};
          skinny_gemm(g.A, g.Bt, NIN, DM, 32 * (NIN / 256), e, lds, lane, wave); }
    }
    SEAM(pb + 0);
    if (IN(pb + 1)) { TIDX(); phase_prep_rows(a, LAYER, gw, NGW, lane); }
    SEAM(pb + 1);
    if (IN(pb + 2)) {
        { pg8::Gemm g{WSP(bf16_t, WS_CQN), WSP(const bf16_t, WB + OFF_WUQ), R, NQ, 1536}; pg8::StaticOrder S; S.init(NB * SEQ, NQ, (int)gridDim.x, (int)blockIdx.x);
          pg8::EpiBf E{WSP(bf16_t, WS_QM), NQ, 1 << 30, 6, nullptr, 0, WSP(float, WS_CS), nullptr};
          pg8::gemm_phase<pg8::EpiBf, pg8::StaticOrder, true, true>(lds, g, S, E, wave_s);
          __syncthreads();
          TIDX(); (void)tid; const SkEmit e{0, WSP(bf16_t, WS_QM), NQ, 1 << 30, nullptr, 0, 1536, WSP(float, WS_CS), nullptr, nullptr, nullptr};
          skinny_gemm(g.A, g.Bt, NQ, 1536, 32 * (NQ / 256), e, lds, lane, wave); }
        __syncthreads();
        { pg8::Gemm g{WSP(bf16_t, WS_CKVN), WSP(const bf16_t, WB + OFF_WUKV), R, NKV, 512}; pg8::StaticOrder S; S.init(NB * SEQ, NKV, (int)gridDim.x, (int)((blockIdx.x + gridDim.x / 2) % gridDim.x));
          pg8::EpiBf E{WSP(bf16_t, WS_KVM), NKV, 1 << 30, 1 << 30, nullptr, 0, WSP(float, WS_CS), nullptr};
          pg8::gemm_phase<pg8::EpiBf, pg8::StaticOrder, true, true>(lds, g, S, E, wave_s);
          __syncthreads();
          TIDX(); (void)tid; const SkEmit e{0, WSP(bf16_t, WS_KVM), NKV, 1 << 30, nullptr, 0, 1 << 30, WSP(float, WS_CS), nullptr, nullptr, nullptr};
          skinny_gemm(g.A, g.Bt, NKV, 512, 32 * (NKV / 256), e, lds, lane, wave); }
        __syncthreads();
        { TIDX(); phase_fcum(a, gw, lane); phase_gla_b1(a, lds, tid, lane, wave); }
    }
    SEAM(pb + 2);
    if (IN(pb + 3)) { TIDX(); phase_gla_b2(a, tid); }
    SEAM(pb + 3);
    if (IN(pb + 4)) { TIDX(); phase_attn2(a, lds, tid, lane, wave); __syncthreads(); phase_gla_b3(a, lds, tid, lane, wave); }
    SEAM2(pb + 4, pb + 6);
    if (IN(pb + 6)) {
        pg8::Gemm g{WSP(bf16_t, WS_MIX), WSP(const bf16_t, WB + OFF_WOUT), R, DM, DM}; pg8::StaticOrder S; S.init(NB * SEQ, DM, (int)gridDim.x, (int)blockIdx.x);
        pg8::EpiRes<false> E{WSP(bf16_t, WS_H), DM, nullptr};
        pg8::gemm_phase<pg8::EpiRes<false>, pg8::StaticOrder, true, true>(lds, g, S, E, wave_s);
        __syncthreads();
        { TIDX(); (void)tid; unsigned long long* const SSQ_ = nullptr; const SkEmit e{2, nullptr, 0, 0, nullptr, 0, 1 << 30, nullptr, WSP(bf16_t, WS_H), nullptr, SSQ_};
          skinny_gemm(g.A, g.Bt, DM, DM, 32 * (DM / 256), e, lds, lane, wave); }
    }
    SEAM(pb + 6);
    if (IN(pb + 7)) { TIDX(); norm_rows<3>(a, nullptr, gw, NGW, lane); }
    SEAM(pb + 7);
    if (IN(pb + 8)) {
        pg8::Gemm g{WSP(bf16_t, WS_HN), WSP(const bf16_t, WB + OFF_WUP), R, NUP, DM}; pg8::StaticOrder S; S.init(NB * SEQ, NUP, (int)gridDim.x, (int)blockIdx.x);
        pg8::Gemm gq{(const bf16_t*)(a.ws + WS_HNQ), (const bf16_t*)(a.ws + WS_WQ + (size_t)LAYER * SZ_WQ), R, NUP, DM / 2};
        pg8::EpiConv<true> E{WSP(bf16_t, WS_ACT), WSP(float, WS_EDGE), a.in[17] + (size_t)LAYER * 3 * NUP, a.in[18] + (size_t)LAYER * NUP, (LAS float*)(lds + MISC_OFF + 1024), WSP(const float, WS_ASC), WSP(const float, WS_WSC) + (size_t)LAYER * NUP};
        pg8::gemm_phase<pg8::EpiConv<true>, pg8::StaticOrder, true, true, true>(lds, gq, S, E, wave_s);
        __syncthreads();
        { TIDX(); (void)tid; const SkEmit e{3, nullptr, 0, 0, WSP(float, WS_UM), NUP, 1 << 30, nullptr, nullptr, nullptr, nullptr};
          skinny_gemm_i8(a.ws + WS_HNQ, a.ws + WS_WQ + (size_t)LAYER * SZ_WQ, NUP, 32 * (NUP / 256), WSP(const float, WS_ASC), WSP(const float, WS_WSC) + (size_t)LAYER * NUP, e, lds, lane, wave); (void)g; }
    }
    SEAM(pb + 8);
    if (IN(pb + 9)) { TIDX(); phase_convfix(a, LAYER, tid); }
    SEAM(pb + 9);
    if (IN(pb + 10)) {
        pg8::Gemm g{WSP(bf16_t, WS_ACT), WSP(const bf16_t, WB + OFF_WDN), R, DM, DFF}; pg8::StaticOrder S; S.init(NB * SEQ, DM, (int)gridDim.x, (int)blockIdx.x);
        unsigned long long* const SSQ_ = LAYER == 0 ? (unsigned long long*)(a.ws + WS_SS1) : nullptr;
        pg8::EpiRes<LAYER == 0> E{WSP(bf16_t, WS_H), DM, SSQ_};
        pg8::gemm_phase<pg8::EpiRes<LAYER == 0>, pg8::StaticOrder, true, true>(lds, g, S, E, wave_s);
        __syncthreads();
        { TIDX(); (void)tid; const SkEmit e{2, nullptr, 0, 0, nullptr, 0, 1 << 30, nullptr, WSP(bf16_t, WS_H), nullptr, SSQ_};
          skinny_gemm(g.A, g.Bt, DM, DFF, 32 * (DM / 256), e, lds, lane, wave); }
    }
    if (LAYER == 0) { SEAM2(pb + 10, pb + 12); }
    else { SEAM(pb + 10); if (IN(pb + 11)) { TIDX(); norm_rows<2>(a, a.in[20], gw, NGW, lane); } }
}
__global__ void __launch_bounds__(512, 2) fwd(Args a) {
    extern __shared__ __attribute__((aligned(16))) unsigned char lds_raw[];
    LAS unsigned char* lds = (LAS unsigned char*)lds_raw;
    const int lo = a.ph_lo, hi = a.ph_hi; const int wave_s = __builtin_amdgcn_readfirstlane(threadIdx.x >> 6);
    volatile LAS unsigned* MISC = (volatile LAS unsigned*)(lds + MISC_OFF);
    if (threadIdx.x < 64) MISC[threadIdx.x] = 0u;
    __syncthreads();
    XcdBarrier bar; bar.bar = (unsigned*)(a.ws + WS_CTL) + CW_BAR; bar.x = 0; bar.st = MISC + 8; bar.w0 = wave_s == 0 ? 1u : 0u;
    if (hi - lo > 1) { bar = xcd_barrier_post((unsigned*)(a.ws + WS_CTL) + CW_BAR, MISC + 8); bar.w0 = wave_s == 0 ? 1u : 0u; }
    if (IN(0)) { { TIDX(); for (int s = blockIdx.x; s < 2 * (NUP / 32); s += gridDim.x) prep_wup_strip(a, lds, s, tid, wave_s); __syncthreads(); }
                 { TIDX(); phase_prologue(a, lds, tid, lane, wave); } }
    SEAM(0);
    layer_phases<0>(a, bar, lds, lo, hi, wave_s);
    layer_phases<1>(a, bar, lds, lo, hi, wave_s);
}
#undef IN
#undef SEAM

#ifndef N_LAUNCH_MODE
#define N_LAUNCH_MODE 1
#endif
extern "C" void kernel_launch(void* const* d_in, const int* in_sizes, int n_in, void* d_out, int out_size, void* d_ws, size_t ws_size, hipStream_t stream) {
    static int grid = 0;
    if (grid == 0) {
        if (n_in != 21 || out_size != NB * SEQ * DM || ws_size < WS_END) { fprintf(stderr, "kernel_launch: unexpected shapes (n_in %d, out %d, ws %zu, need %zu)\n", n_in, out_size, ws_size, (size_t)WS_END); grid = -1; return; }
        int dev = 0, cus = 0;
        if (hipGetDevice(&dev) != hipSuccess || hipDeviceGetAttribute(&cus, hipDeviceAttributeMultiprocessorCount, dev) != hipSuccess || cus <= 0) { grid = -1; return; }
        if (hipFuncSetAttribute((const void*)fwd, hipFuncAttributeMaxDynamicSharedMemorySize, LDS_BYTES) != hipSuccess) { fprintf(stderr, "kernel_launch: hipFuncSetAttribute failed\n"); grid = -1; return; }
        int per_cu = 0;
        if (hipOccupancyMaxActiveBlocksPerMultiprocessor(&per_cu, (const void*)fwd, 512, LDS_BYTES) != hipSuccess || per_cu < 1) fprintf(stderr, "kernel_launch: occupancy query reports %d\n", per_cu);
        (void)hipGetLastError();
        grid = cus;
    }
    if (grid < 0) return;
    (void)hipMemsetAsync((char*)d_ws + WS_CTL, 0, CTL_ZERO_BYTES, stream);
    Args a{};
    for (int i = 0; i < 21; ++i) a.in[i] = (const float*)d_in[i];
    a.out = (float*)d_out; a.ws = (unsigned char*)d_ws;
#if N_LAUNCH_MODE == 1
    a.ph_lo = 0; a.ph_hi = NPHASES;
    hipLaunchKernelGGL(fwd, dim3(grid), dim3(512), LDS_BYTES, stream, a);
#else
    for (int ph = 0; ph < NPHASES; ++ph) { a.ph_lo = ph; a.ph_hi = ph + 1; hipLaunchKernelGGL(fwd, dim3(grid), dim3(512), LDS_BYTES, stream, a); }
#endif
}
```

```cpp
#include <hip/hip_runtime.h>
#include <cstdio>
#include <cstdint>
namespace pg8 {
#define PG8_LAS __attribute__((address_space(3)))
typedef unsigned short bf16_t;
typedef short bf16x8 __attribute__((ext_vector_type(8)));
typedef float f32x4 __attribute__((ext_vector_type(4)));
typedef unsigned u32x4 __attribute__((ext_vector_type(4)));
constexpr int BM = 256, BK = 64, HALF = 128, HTB = HALF * BK * 2  , STAGE_BYTES = 8 * HTB, NXCD = 8, WGM = 8;

__host__ __device__ __forceinline__ int lds_byte(int r, int c) { const int st = (r >> 4) * 2 + (c >> 5), rr = r & 15, cc = c & 31, ob = rr * 64 + cc * 2; return st * 1024 + (ob ^ (((ob >> 9) & 1) << 5)); }
__host__ __device__ __forceinline__ void stage_rc(int b, int& R, int& C) { const int st = b / 1024, sb = b % 1024, swz = sb ^ (((sb >> 9) & 1) << 5); R = (st >> 1) * 16 + swz / 64; C = (st & 1) * 32 + (swz % 64) / 2; }
__host__ __device__ __forceinline__ int perm32(int rho) { const int n = rho >> 4, i = rho & 15; return 8 * (i >> 2) + 4 * n + (i & 3); }

struct Unit { int pm, pn; };
__host__ __device__ __forceinline__ int prow(int pm) { return (pm >> 4) * 4224 + 128 + (pm & 15) * 256; }
struct Gemm { const bf16_t* A; const bf16_t* Bt; int M, N, K; };

struct StaticOrder {
    int nM, nN, nwg, G, c;
    __host__ __device__ void init(int M, int N, int G_, int c_) { nM = M / BM; nN = N / BM; nwg = nM * nN; G = G_; c = c_; }
    __host__ __device__ bool next(int i, Unit& u) const {
        const long L = (long)i * G + c; if (L >= nwg) return false;
        int wgid = (int)L; { const int q = nwg / NXCD, r = nwg % NXCD, xcd = wgid % NXCD, off = wgid / NXCD; wgid = (xcd < r ? xcd * (q + 1) : r * (q + 1) + (xcd - r) * q) + off; }
        const int nig = WGM * nN, gid = wgid / nig, fm = gid * WGM, gsz = (nM - fm) < WGM ? (nM - fm) : WGM;
        u.pm = fm + ((wgid % nig) % gsz); u.pn = (wgid % nig) / gsz; return true;
    }
    __device__ __forceinline__ void a_ready(const Unit&) const {}
    __device__ __forceinline__ void done(const Unit&) const {}
};
typedef int i32x4 __attribute__((ext_vector_type(4)));
template <bool I8> struct AccSel { typedef f32x4 type; };
template <> struct AccSel<true> { typedef i32x4 type; };
__device__ __forceinline__ unsigned cvt_pk_bf16(float lo, float hi) { unsigned r; asm volatile("v_cvt_pk_bf16_f32 %0, %1, %2" : "=v"(r) : "v"(lo), "v"(hi)); return r; }
constexpr int EPI_LROWS = 4224, EPI_NPAD = 112;
struct EpiBf {
    static constexpr bool PERM = true, AFTER_DRAIN = false, APERM = false;
    bf16_t* O; int ldc; int nbf; int rope_from; float* F; int ldf; const float* cs; const unsigned long long* ssq;
    __device__ __forceinline__ void operator()(const f32x4 (&acc)[2][2][4][2], const Unit& u, int wr, int wc, int fr, int fq) const {
        const int row0 = prow(u.pm) + wr * 64 + fr, col0 = u.pn * BM + wc * 32 + 8 * fq;
        float rsc[2][4];
        if (ssq) { unsigned long long q[2][4];
#pragma unroll
            for (int ai = 0; ai < 2; ++ai)
#pragma unroll
                for (int m = 0; m < 4; ++m) q[ai][m] = ssq[row0 + ai * HALF + m * 16];
#pragma unroll
            for (int ai = 0; ai < 2; ++ai)
#pragma unroll
                for (int m = 0; m < 4; ++m) rsc[ai][m] = 1.0f / sqrtf((float)q[ai][m] * (1.0f / 4294967296.0f / 4096.0f) + 1e-6f);
        } else {
#pragma unroll
            for (int ai = 0; ai < 2; ++ai)
#pragma unroll
                for (int m = 0; m < 4; ++m) rsc[ai][m] = 1.0f;
        }
        if (u.pn < nbf) {
            const bool rope = u.pn >= rope_from;
#pragma unroll
            for (int ai = 0; ai < 2; ++ai)
#pragma unroll
                for (int m = 0; m < 4; ++m) { const int row = row0 + ai * HALF + m * 16; bf16_t* rowp = O + (size_t)row * ldc + col0;
#pragma unroll
                    for (int bj = 0; bj < 2; ++bj) { f32x4 v0 = acc[ai][bj][m][0] * rsc[ai][m], v1 = acc[ai][bj][m][1] * rsc[ai][m];
                        if (rope) { const int p = row % EPI_LROWS, i0 = ((col0 + bj * HALF) & 63) >> 1; const float* t = cs + ((size_t)p * 32 + i0) * 2;
                            const f32x4 t0 = *(const f32x4*)t, t1 = *(const f32x4*)(t + 4);
                            const f32x4 a = v0, b = v1;
                            v0[0] = a[0] * t0[0] - a[1] * t0[1]; v0[1] = a[1] * t0[0] + a[0] * t0[1]; v0[2] = a[2] * t0[2] - a[3] * t0[3]; v0[3] = a[3] * t0[2] + a[2] * t0[3];
                            v1[0] = b[0] * t1[0] - b[1] * t1[1]; v1[1] = b[1] * t1[0] + b[0] * t1[1]; v1[2] = b[2] * t1[2] - b[3] * t1[3]; v1[3] = b[3] * t1[2] + b[2] * t1[3]; }
                        u32x4 w; w.x = cvt_pk_bf16(v0[0], v0[1]); w.y = cvt_pk_bf16(v0[2], v0[3]); w.z = cvt_pk_bf16(v1[0], v1[1]); w.w = cvt_pk_bf16(v1[2], v1[3]);
                        *(u32x4*)(rowp + bj * HALF) = w; } }
        } else {
            const int fc0 = col0 - nbf * BM;
#pragma unroll
            for (int ai = 0; ai < 2; ++ai)
#pragma unroll
                for (int m = 0; m < 4; ++m) { const int row = row0 + ai * HALF + m * 16; float* rowp = F + (size_t)row * ldf + fc0;
#pragma unroll
                    for (int bj = 0; bj < 2; ++bj) { *(f32x4*)(rowp + bj * HALF) = acc[ai][bj][m][0] * rsc[ai][m]; *(f32x4*)(rowp + bj * HALF + 4) = acc[ai][bj][m][1] * rsc[ai][m]; } }
        }
    }
};
template <bool SSQ> struct EpiRes {
    static constexpr bool PERM = true, AFTER_DRAIN = false, APERM = false;
    bf16_t* H; int ldc; unsigned long long* ssq;
    __device__ __forceinline__ void operator()(const f32x4 (&acc)[2][2][4][2], const Unit& u, int wr, int wc, int fr, int fq) const {
        char* hb = (char*)(H + (size_t)prow(u.pm) * ldc + u.pn * BM);
        const unsigned lo = (unsigned)((wr * 64 + fr) * ldc + wc * 32 + 8 * fq) * 2u;
        u32x4 r[2][4][2];
#pragma unroll
        for (int ai = 0; ai < 2; ++ai)
#pragma unroll
            for (int m = 0; m < 4; ++m)
#pragma unroll
                for (int bj = 0; bj < 2; ++bj) r[ai][m][bj] = *(const u32x4*)(hb + lo + (unsigned)((ai * HALF + m * 16) * ldc + bj * HALF) * 2u);
#pragma unroll
        for (int ai = 0; ai < 2; ++ai)
#pragma unroll
            for (int m = 0; m < 4; ++m)
#pragma unroll
                for (int bj = 0; bj < 2; ++bj) { const u32x4 q = r[ai][m][bj]; const f32x4 v0 = acc[ai][bj][m][0], v1 = acc[ai][bj][m][1]; u32x4 w;
                    w.x = cvt_pk_bf16(v0[0] + __uint_as_float(q.x << 16), v0[1] + __uint_as_float(q.x & 0xffff0000u));
                    w.y = cvt_pk_bf16(v0[2] + __uint_as_float(q.y << 16), v0[3] + __uint_as_float(q.y & 0xffff0000u));
                    w.z = cvt_pk_bf16(v1[0] + __uint_as_float(q.z << 16), v1[1] + __uint_as_float(q.z & 0xffff0000u));
                    w.w = cvt_pk_bf16(v1[2] + __uint_as_float(q.w << 16), v1[3] + __uint_as_float(q.w & 0xffff0000u));
                    *(u32x4*)(hb + lo + (unsigned)((ai * HALF + m * 16) * ldc + bj * HALF) * 2u) = w;
                    if constexpr (SSQ) { r[ai][m][bj] = w; } }
        if constexpr (SSQ) {
            const int rowb = prow(u.pm) + wr * 64 + fr;
#pragma unroll
            for (int ai = 0; ai < 2; ++ai)
#pragma unroll
                for (int m = 0; m < 4; ++m) { float s = 0.f;
#pragma unroll
                    for (int bj = 0; bj < 2; ++bj) { const u32x4 w = r[ai][m][bj];
#pragma unroll
                        for (int e = 0; e < 4; ++e) { const float x0 = __uint_as_float(w[e] << 16), x1 = __uint_as_float(w[e] & 0xffff0000u); s += x0 * x0 + x1 * x1; } }
                    s += __shfl_xor(s, 16); s += __shfl_xor(s, 32);
                    if (fq == 0) atomicAdd(ssq + rowb + ai * HALF + m * 16, (unsigned long long)(s * 4294967296.0f)); }
        }
    }
};
template <bool I8> struct EpiConv {
    static constexpr bool PERM = true, AFTER_DRAIN = false, APERM = true;
    bf16_t* ACT; float* EDGE; const float* cw; const float* cb; PG8_LAS float* EX; const float* asc; const float* wsc;
    static __device__ __forceinline__ float shr1(float oldv, float src) { return __int_as_float(__builtin_amdgcn_update_dpp(__float_as_int(oldv), __float_as_int(src), 0x111, 0xf, 0xf, false)); }
    __device__ __forceinline__ void operator()(typename AccSel<I8>::type (&acc)[2][2][4][2], const Unit& u, int wr, int wc, int fr_in, int fq_in) const {
        constexpr int NUPc = 22016, DFFc = 11008;
        (void)fr_in; (void)fq_in; int ln_; asm volatile("v_mbcnt_lo_u32_b32 %0, -1, 0\n\tv_mbcnt_hi_u32_b32 %0, -1, %0" : "=v"(ln_));
        int fr = ln_ & 15, fq = ln_ >> 4;
        const int chb = wc * 32 + 8 * fq, prow0 = prow(u.pm);
#define EC_F(ai_, bj_, m_, n_) __builtin_bit_cast(f32x4, acc[ai_][bj_][m_][n_])
        PG8_LAS float* CWL = EX + 2048;
        PG8_LAS float* WSL = EX + 2048 + 1024;
        PG8_LAS float* ASL = EX + 2048 + 1024 + 256;
        {
            const int t_ = (wr * 4 + wc) * 64 + ln_;
            if (t_ < 256) { const int v = t_ >> 5, c4 = (t_ & 31) * 4, vv = v & 3; const float* sp = (vv < 3 ? cw + vv * NUPc : cb) + (v >> 2) * DFFc + u.pn * 128 + c4;
                *(PG8_LAS f32x4*)(CWL + v * 128 + c4) = *(const f32x4*)sp; }
            else if (I8 && t_ < 320) { const int j = t_ - 256; *(PG8_LAS f32x4*)(WSL + 4 * j) = *(const f32x4*)(wsc + u.pn * 256 + 4 * j); }
            else if (I8 && t_ < 384) { const int j = t_ - 320; *(PG8_LAS f32x4*)(ASL + 4 * j) = *(const f32x4*)(asc + prow0 + 4 * j); }
        }
        asm volatile("s_waitcnt vmcnt(0) lgkmcnt(0)" ::: "memory"); __builtin_amdgcn_s_barrier(); asm volatile("" ::: "memory");
        if constexpr (I8) {
            f32x4 as_[2];
#pragma unroll
            for (int ai = 0; ai < 2; ++ai) as_[ai] = *(const PG8_LAS f32x4*)(ASL + 128 * ai + 64 * wr + 4 * fr);
#pragma unroll
            for (int bj = 0; bj < 2; ++bj)
#pragma unroll
                for (int n = 0; n < 2; ++n) { const f32x4 wsv = *(const PG8_LAS f32x4*)(WSL + bj * 128 + chb + 4 * n);
#pragma unroll
                    for (int ai = 0; ai < 2; ++ai)
#pragma unroll
                        for (int m = 0; m < 4; ++m) { const i32x4 q = __builtin_bit_cast(i32x4, acc[ai][bj][m][n]); f32x4 f; f[0] = (float)q[0]; f[1] = (float)q[1]; f[2] = (float)q[2]; f[3] = (float)q[3];
                            f = f * wsv * as_[ai][m]; acc[ai][bj][m][n] = __builtin_bit_cast(typename AccSel<I8>::type, f); } }
        }
        if (fr == 15) {
#pragma unroll
            for (int ai = 0; ai < 2; ++ai)
#pragma unroll
                for (int mm = 2; mm < 4; ++mm)
#pragma unroll
                    for (int bj = 0; bj < 2; ++bj)
#pragma unroll
                        for (int n = 0; n < 2; ++n) *(PG8_LAS f32x4*)(EX + (((2 * ai + wr) * 2 + (mm - 2)) * 256 + bj * 128 + chb + 4 * n)) = EC_F(ai, bj, mm, n);
        }
        char* eg = (char*)(EDGE + (size_t)u.pm * 4 * NUPc + u.pn * 256);
        if (wr == 0 && fr == 0) {
#pragma unroll
            for (int mm = 0; mm < 2; ++mm)
#pragma unroll
                for (int bj = 0; bj < 2; ++bj)
#pragma unroll
                    for (int n = 0; n < 2; ++n) *(f32x4*)(eg + (unsigned)(mm * NUPc + chb) * 4u + (bj * 128 + 4 * n) * 4) = EC_F(0, bj, mm, n);
        }
        if (wr == 1 && fr == 15) {
#pragma unroll
            for (int mm = 2; mm < 4; ++mm)
#pragma unroll
                for (int bj = 0; bj < 2; ++bj)
#pragma unroll
                    for (int n = 0; n < 2; ++n) *(f32x4*)(eg + (unsigned)(mm * NUPc + chb) * 4u + (bj * 128 + 4 * n) * 4) = EC_F(1, bj, mm, n);
        }
        asm volatile("s_waitcnt lgkmcnt(0)" ::: "memory"); __builtin_amdgcn_s_barrier(); asm volatile("" ::: "memory");
        unsigned pk0[2][4][2];
#pragma unroll
        for (int n = 0; n < 2; ++n) {
            asm volatile("" : "+v"(fr));
            const int ch = u.pn * 128 + chb + 4 * n;
            const PG8_LAS float* cwl = CWL + chb + 4 * n;
            const f32x4 wg0 = *(const PG8_LAS f32x4*)cwl, wg1 = *(const PG8_LAS f32x4*)(cwl + 128), wg2 = *(const PG8_LAS f32x4*)(cwl + 256), bg = *(const PG8_LAS f32x4*)(cwl + 384);
            const f32x4 wv0 = *(const PG8_LAS f32x4*)(cwl + 512), wv1 = *(const PG8_LAS f32x4*)(cwl + 640), wv2 = *(const PG8_LAS f32x4*)(cwl + 768), bv = *(const PG8_LAS f32x4*)(cwl + 896);
#pragma unroll
            for (int ai = 0; ai < 2; ++ai) {
                const int q = 2 * ai + wr;
                f32x4 hg1 = {0.f, 0.f, 0.f, 0.f}, hg2 = hg1, hv1 = hg1, hv2 = hg1;
                if (q >= 1) { const PG8_LAS float* hx = EX + ((q - 1) * 2) * 256 + chb + 4 * n;
                    hg2 = *(const PG8_LAS f32x4*)hx; hg1 = *(const PG8_LAS f32x4*)(hx + 256); hv2 = *(const PG8_LAS f32x4*)(hx + 128); hv1 = *(const PG8_LAS f32x4*)(hx + 256 + 128); }
                float o[4][4];
#pragma unroll
                for (int e = 0; e < 4; ++e) {
                    const float g0 = EC_F(ai, 0, 0, n)[e], g1 = EC_F(ai, 0, 1, n)[e], g2 = EC_F(ai, 0, 2, n)[e], g3 = EC_F(ai, 0, 3, n)[e];
                    const float v0 = EC_F(ai, 1, 0, n)[e], v1 = EC_F(ai, 1, 1, n)[e], v2 = EC_F(ai, 1, 2, n)[e], v3 = EC_F(ai, 1, 3, n)[e];
                    const float gm1 = shr1(hg1[e], g3), gm2 = shr1(hg2[e], g2), vm1 = shr1(hv1[e], v3), vm2 = shr1(hv2[e], v2);
                    const float cg0 = bg[e] + wg0[e] * gm2 + wg1[e] * gm1 + wg2[e] * g0, cv0 = bv[e] + wv0[e] * vm2 + wv1[e] * vm1 + wv2[e] * v0;
                    const float cg1 = bg[e] + wg0[e] * gm1 + wg1[e] * g0 + wg2[e] * g1, cv1 = bv[e] + wv0[e] * vm1 + wv1[e] * v0 + wv2[e] * v1;
                    const float cg2 = bg[e] + wg0[e] * g0 + wg1[e] * g1 + wg2[e] * g2, cv2 = bv[e] + wv0[e] * v0 + wv1[e] * v1 + wv2[e] * v2;
                    const float cg3 = bg[e] + wg0[e] * g1 + wg1[e] * g2 + wg2[e] * g3, cv3 = bv[e] + wv0[e] * v1 + wv1[e] * v2 + wv2[e] * v3;
                    o[0][e] = cg0 * __builtin_amdgcn_rcpf(1.0f + __expf(-cg0)) * cv0; o[1][e] = cg1 * __builtin_amdgcn_rcpf(1.0f + __expf(-cg1)) * cv1;
                    o[2][e] = cg2 * __builtin_amdgcn_rcpf(1.0f + __expf(-cg2)) * cv2; o[3][e] = cg3 * __builtin_amdgcn_rcpf(1.0f + __expf(-cg3)) * cv3;
                }
#pragma unroll
                for (int m = 0; m < 4; ++m) {
                    if (n == 0) { pk0[ai][m][0] = cvt_pk_bf16(o[m][0], o[m][1]); pk0[ai][m][1] = cvt_pk_bf16(o[m][2], o[m][3]); }
                    else if (!(q == 0 && fr == 0 && m < 2)) {
                        u32x4 w; w.x = pk0[ai][m][0]; w.y = pk0[ai][m][1]; w.z = cvt_pk_bf16(o[m][0], o[m][1]); w.w = cvt_pk_bf16(o[m][2], o[m][3]);
                        *(u32x4*)(ACT + (size_t)(prow0 + 128 * ai + 64 * wr + 4 * fr + m) * DFFc + (ch - 4)) = w;
                    }
                }
            }
        }
    }
#undef EC_F
};
template <class Epi, class Sched, bool ALIGN_EPI = false, bool SP2 = false, bool I8 = false>
__device__ __forceinline__ void gemm_phase(PG8_LAS unsigned char* lds, const Gemm g, const Sched& S, const Epi& E, const int wave_s) {
    int lane_; asm volatile("v_mbcnt_lo_u32_b32 %0, -1, 0\n\tv_mbcnt_hi_u32_b32 %0, -1, %0" : "=v"(lane_));
    const int wid = wave_s, lane = lane_, tid = wid * 64 + lane, wr = wid >> 2, wc = wid & 3, fr = lane & 15, fq = lane >> 4;
    const int K = g.K, nt = K / BK;
    unsigned voffA[2], voffB[2];
#pragma unroll
    for (int i = 0; i < 2; ++i) { int R, C; stage_rc(tid * 16 + i * 8192, R, C); const int Rb = Epi::PERM ? ((R & ~31) + perm32(R & 31)) : R;
        const int Ra = Epi::APERM ? ((R & ~63) + 4 * (R & 15) + ((R >> 4) & 3)) : R;
        voffA[i] = (unsigned)(Ra * K + C) * 2u; voffB[i] = (unsigned)(Rb * K + C) * 2u; }
    const size_t kstep = (size_t)(BK * 2);
    const size_t hstep = (size_t)HALF * K * 2;
    const size_t tstep = 2 * hstep;
    const unsigned ldsw = (unsigned)wid * 1024u;
    const int aoff = lds_byte(wr * 64 + fr, fq * 8), boff = lds_byte(wc * 32 + fr, fq * 8);
#define PG8_SA(b, h) (((b) * 2 + (h)) * HTB)
#define PG8_SB(b, h) ((4 + (b) * 2 + (h)) * HTB)
#define PG8_STAGE(bufoff, gbase, voff) do { _Pragma("unroll") for (int _i = 0; _i < 2; ++_i) \
        __builtin_amdgcn_global_load_lds((const unsigned*)((const char*)(gbase) + (voff)[_i]), (PG8_LAS unsigned*)(lds + (bufoff) + ldsw + _i * 8192), 16, 0, 0); } while (0)
#define PG8_LDA(dst, b, h) do { _Pragma("unroll") for (int m = 0; m < 4; ++m) _Pragma("unroll") for (int k = 0; k < 2; ++k) dst[m][k] = *(const PG8_LAS bf16x8*)(lds + PG8_SA(b, h) + aoff + m * 2048 + k * 1024); } while (0)
#define PG8_LDB(dst, b, h) do { _Pragma("unroll") for (int n = 0; n < 2; ++n) _Pragma("unroll") for (int k = 0; k < 2; ++k) dst[n][k] = *(const PG8_LAS bf16x8*)(lds + PG8_SB(b, h) + boff + n * 2048 + k * 1024); } while (0)
#define PG8_MMA(ai, bj, At, Bt) do { __builtin_amdgcn_s_setprio(1); _Pragma("unroll") for (int m = 0; m < 4; ++m) _Pragma("unroll") for (int n = 0; n < 2; ++n) _Pragma("unroll") for (int k = 0; k < 2; ++k) { \
        if constexpr (I8) acc[ai][bj][m][n] = __builtin_bit_cast(acc_t, __builtin_amdgcn_mfma_i32_16x16x64_i8(__builtin_bit_cast(i32x4, Bt[n][k]), __builtin_bit_cast(i32x4, At[m][k]), __builtin_bit_cast(i32x4, acc[ai][bj][m][n]), 0, 0, 0)); \
        else acc[ai][bj][m][n] = __builtin_bit_cast(acc_t, __builtin_amdgcn_mfma_f32_16x16x32_bf16(Bt[n][k], At[m][k], __builtin_bit_cast(f32x4, acc[ai][bj][m][n]), 0, 0, 0)); } \
        __builtin_amdgcn_s_setprio(0); } while (0)
#define PG8_WAIT_V(n) asm volatile("s_waitcnt vmcnt(" #n ")" ::: "memory")
#define PG8_WAIT_L(n) asm volatile("s_waitcnt lgkmcnt(" #n ")" ::: "memory")
#define PG8_BAR __builtin_amdgcn_s_barrier()
#define PG8_SCHED __builtin_amdgcn_sched_barrier(0)
    Unit cur, nxt; int ui = 0;
    if (!S.next(0, cur)) return;
    typedef typename AccSel<I8>::type acc_t;
    acc_t acc[2][2][4][2];
#pragma unroll
    for (int a = 0; a < 2; ++a)
#pragma unroll
        for (int b = 0; b < 2; ++b)
#pragma unroll
            for (int m = 0; m < 4; ++m)
#pragma unroll
                for (int n = 0; n < 2; ++n) acc[a][b][m][n] = __builtin_bit_cast(acc_t, (f32x4){0.f, 0.f, 0.f, 0.f});
    bf16x8 At[4][2], B0[2][2], B1[2][2];
    const char* cA = (const char*)g.A + (size_t)prow(cur.pm) * K * 2; const char* cB = (const char*)g.Bt + (size_t)cur.pn * tstep;
    S.a_ready(cur);
    if constexpr (SP2) {
        PG8_STAGE(PG8_SB(0, 0), cB, voffB); PG8_STAGE(PG8_SB(0, 1), cB + hstep, voffB); PG8_STAGE(PG8_SA(0, 0), cA, voffA); PG8_STAGE(PG8_SA(0, 1), cA + hstep, voffA);
        if (wr == 1) PG8_BAR;
        PG8_WAIT_V(2); PG8_BAR;
        PG8_STAGE(PG8_SB(1, 0), cB + kstep, voffB); PG8_STAGE(PG8_SA(1, 0), cA + kstep, voffA); PG8_STAGE(PG8_SB(1, 1), cB + hstep + kstep, voffB);
        PG8_WAIT_V(6); PG8_BAR;
    } else {
        PG8_STAGE(PG8_SB(0, 0), cB, voffB); PG8_STAGE(PG8_SA(0, 0), cA, voffA); PG8_STAGE(PG8_SB(0, 1), cB + hstep, voffB); PG8_STAGE(PG8_SA(0, 1), cA + hstep, voffA);
        if (wr == 1) PG8_BAR;
        PG8_WAIT_V(4); PG8_BAR;
        PG8_STAGE(PG8_SB(1, 0), cB + kstep, voffB); PG8_STAGE(PG8_SA(1, 0), cA + kstep, voffA); PG8_STAGE(PG8_SB(1, 1), cB + hstep + kstep, voffB);
        PG8_WAIT_V(6); PG8_BAR;
    }
    for (;;) {
        const bool has_next = S.next(ui + 1, nxt);
        const char* nA = has_next ? (const char*)g.A + (size_t)prow(nxt.pm) * K * 2 : cA; const char* nB = has_next ? (const char*)g.Bt + (size_t)nxt.pn * tstep : cB;
        for (int t = 0; t < nt; t += 2) {
            const bool last = (t == nt - 2);
            const char* a1 = cA + (size_t)(t + 1) * kstep;
            const char* a2 = last ? nA : cA + (size_t)(t + 2) * kstep; const char* b2 = last ? nB : cB + (size_t)(t + 2) * kstep;
            const char* a3 = a2 + kstep; const char* b3 = b2 + kstep;
            if (last && has_next) S.a_ready(nxt);
            if constexpr (SP2) {
            PG8_LDB(B0, 0, 0); PG8_LDB(B1, 0, 1); PG8_SCHED; PG8_LDA(At, 0, 0); PG8_STAGE(PG8_SA(1, 1), a1 + hstep, voffA);
            PG8_WAIT_V(8); PG8_WAIT_L(0); PG8_BAR; PG8_MMA(0, 0, At, B0); PG8_MMA(0, 1, At, B1); PG8_BAR; PG8_SCHED;
            PG8_LDA(At, 0, 1); PG8_STAGE(PG8_SB(0, 0), b2, voffB); PG8_STAGE(PG8_SB(0, 1), b2 + hstep, voffB); PG8_STAGE(PG8_SA(0, 0), a2, voffA);
            PG8_WAIT_V(8); PG8_WAIT_L(0); PG8_BAR; PG8_MMA(1, 0, At, B0); PG8_MMA(1, 1, At, B1); PG8_BAR; PG8_SCHED;
            PG8_LDB(B0, 1, 0); PG8_LDB(B1, 1, 1); PG8_SCHED; PG8_LDA(At, 1, 0); PG8_STAGE(PG8_SA(0, 1), a2 + hstep, voffA);
            PG8_WAIT_V(8); PG8_WAIT_L(0); PG8_BAR; PG8_MMA(0, 0, At, B0); PG8_MMA(0, 1, At, B1); PG8_BAR; PG8_SCHED;
            PG8_LDA(At, 1, 1); PG8_STAGE(PG8_SB(1, 0), b3, voffB); PG8_STAGE(PG8_SB(1, 1), b3 + hstep, voffB); PG8_STAGE(PG8_SA(1, 0), a3, voffA);
            PG8_WAIT_V(8); PG8_WAIT_L(0); PG8_BAR; PG8_MMA(1, 0, At, B0); PG8_MMA(1, 1, At, B1); PG8_BAR; PG8_SCHED;
            } else {
            PG8_LDB(B0, 0, 0); PG8_SCHED; PG8_LDA(At, 0, 0); PG8_STAGE(PG8_SA(1, 1), a1 + hstep, voffA);
            PG8_WAIT_L(8); PG8_BAR; PG8_WAIT_L(0); PG8_MMA(0, 0, At, B0); PG8_BAR; PG8_SCHED;
            PG8_LDB(B1, 0, 1); PG8_STAGE(PG8_SB(0, 0), b2, voffB);
            PG8_BAR; PG8_WAIT_L(0); PG8_MMA(0, 1, At, B1); PG8_BAR;
            PG8_LDA(At, 0, 1); PG8_STAGE(PG8_SA(0, 0), a2, voffA);
            PG8_BAR; PG8_WAIT_L(0); PG8_MMA(1, 0, At, B0); PG8_BAR; PG8_SCHED;
            PG8_STAGE(PG8_SB(0, 1), b2 + hstep, voffB);
            PG8_WAIT_V(6); PG8_BAR; PG8_MMA(1, 1, At, B1); PG8_BAR;
            PG8_LDB(B0, 1, 0); PG8_SCHED; PG8_LDA(At, 1, 0); PG8_STAGE(PG8_SA(0, 1), a2 + hstep, voffA);
            PG8_WAIT_L(8); PG8_BAR; PG8_WAIT_L(0); PG8_MMA(0, 0, At, B0); PG8_BAR; PG8_SCHED;
            PG8_LDB(B1, 1, 1); PG8_STAGE(PG8_SB(1, 0), b3, voffB);
            PG8_BAR; PG8_WAIT_L(0); PG8_MMA(0, 1, At, B1); PG8_BAR;
            PG8_LDA(At, 1, 1); PG8_STAGE(PG8_SA(1, 0), a3, voffA);
            PG8_BAR; PG8_WAIT_L(0); PG8_MMA(1, 0, At, B0); PG8_BAR; PG8_SCHED;
            PG8_STAGE(PG8_SB(1, 1), b3 + hstep, voffB);
            PG8_WAIT_V(6); PG8_BAR; PG8_MMA(1, 1, At, B1); PG8_BAR;
            }
        }
        if constexpr (ALIGN_EPI) { if (wr == 0) PG8_BAR; }
        if constexpr (!Epi::AFTER_DRAIN) { E(acc, cur, wr, wc, fr, fq); S.done(cur); }
        if (!has_next) break;
#pragma unroll
        for (int a = 0; a < 2; ++a)
#pragma unroll
            for (int b = 0; b < 2; ++b)
#pragma unroll
                for (int m = 0; m < 4; ++m)
#pragma unroll
                    for (int n = 0; n < 2; ++n) acc[a][b][m][n] = __builtin_bit_cast(acc_t, (f32x4){0.f, 0.f, 0.f, 0.f});
        cur = nxt; cA = nA; cB = nB; ++ui;
        if constexpr (ALIGN_EPI) { if (wr == 1) PG8_BAR; }
    }
    PG8_WAIT_V(0);
    if constexpr (!ALIGN_EPI) { if (wr == 0) PG8_BAR; }
    PG8_BAR;
    if constexpr (Epi::AFTER_DRAIN) { E.fused(acc, cur, wr, wc, fr, fq, lds, wid, lane); S.done(cur); }
#undef PG8_SA
#undef PG8_SB
#undef PG8_STAGE
#undef PG8_LDA
#undef PG8_LDB
#undef PG8_MMA
#undef PG8_WAIT_V
#undef PG8_WAIT_L
#undef PG8_BAR
#undef PG8_SCHED
}
}

#define LAS __attribute__((address_space(3)))
#define XB_TMO      128
#define XB_XCNT(j)  (256  + 64 * (j))
#define XB_XSUB(j)  (1280 + 64 * (j))
#define XB_XGEN(j)  (2304 + 64 * (j))
#define XB_TOP      3328
#define XB_TOPGEN   3392
#define XCD_BAR_WORDS 3456
#define XB_SPIN_CAP (1u << 18)

__device__ __forceinline__ unsigned xb_ld(unsigned* p)              { return __hip_atomic_load(p, __ATOMIC_RELAXED, __HIP_MEMORY_SCOPE_AGENT); }
__device__ __forceinline__ unsigned xb_add(unsigned* p, unsigned v) { return __hip_atomic_fetch_add(p, v, __ATOMIC_RELAXED, __HIP_MEMORY_SCOPE_AGENT); }
__device__ __forceinline__ unsigned xb_xcc_id() { return (unsigned)__builtin_amdgcn_s_getreg((3 << 11) | 20) & 0xFu; }
#define XB_SPIN(cond, bar) do { unsigned _sp = 0; while (cond) { __builtin_amdgcn_s_sleep(1); \
    if ((++_sp & 255u) == 0u) { if (xb_ld(&(bar)[XB_TMO])) break; if (_sp > XB_SPIN_CAP) { atomicAdd(&(bar)[XB_TMO], 1u); break; } } } } while (0)

struct XcdBarrier {
    unsigned* bar; unsigned x; unsigned w0;
    volatile LAS unsigned* st;
};

__device__ __forceinline__ XcdBarrier xcd_barrier_post(unsigned* bar, volatile LAS unsigned* st) {
    XcdBarrier b; b.bar = bar; b.x = xb_xcc_id(); b.st = st; b.w0 = threadIdx.x < 64 ? 1u : 0u;
    if (threadIdx.x == 0) (void)xb_add(&bar[XB_XCNT(b.x)], 1u);
    return b;
}
__device__ __forceinline__ void xcd_barrier_complete(unsigned* bar, unsigned x, unsigned& nloc, unsigned& nx) {
    const unsigned G = gridDim.x * gridDim.y * gridDim.z;
    unsigned sum, cnt, mine, sp = 0u;
    for (;;) {
        sum = 0u; cnt = 0u; mine = 0u;
#pragma unroll
        for (unsigned j = 0; j < 16; ++j) { const unsigned c = xb_ld(&bar[XB_XCNT(j)]); sum += c; cnt += (c > 0u) ? 1u : 0u; mine = (j == x) ? c : mine; }
        if (sum == G) break;
        __builtin_amdgcn_s_sleep(1);
        if ((++sp & 255u) == 0u) { if (xb_ld(&bar[XB_TMO])) break; if (sp > XB_SPIN_CAP) { atomicAdd(&bar[XB_TMO], 1u); break; } }
    }
    nloc = mine > 0u ? mine : 1u; nx = cnt > 0u ? cnt : 1u;
}

__device__ __forceinline__ void xcd_barrier(const XcdBarrier& b) {
    asm volatile("s_waitcnt vmcnt(0)" ::: "memory");
    __syncthreads();
    int xb_lane; asm volatile("v_mbcnt_lo_u32_b32 %0, -1, 0\n\tv_mbcnt_hi_u32_b32 %0, -1, %0" : "=v"(xb_lane));
    if (b.w0 != 0u && xb_lane == 0) {
        unsigned* bar = b.bar;
        __builtin_amdgcn_s_waitcnt(0);
        unsigned nloc = b.st[0], nx = b.st[1];
        if (nloc == 0u) { xcd_barrier_complete(bar, b.x, nloc, nx); b.st[0] = nloc; b.st[1] = nx; }
        const unsigned old = xb_add(&bar[XB_XSUB(b.x)], 1u);
        const unsigned gen = old / nloc;
        if (old + 1u == (gen + 1u) * nloc) {
            __builtin_amdgcn_fence(__ATOMIC_RELEASE, "agent");
            asm volatile("s_waitcnt vmcnt(0)" ::: "memory");
            const unsigned og = xb_add(&bar[XB_TOP], 1u);
            const unsigned tg = og / nx;
            if (og + 1u == (tg + 1u) * nx) xb_add(&bar[XB_TOPGEN], 1u);
            else XB_SPIN(xb_ld(&bar[XB_TOPGEN]) == tg, bar);
            __builtin_amdgcn_fence(__ATOMIC_ACQUIRE, "agent");
            xb_add(&bar[XB_XGEN(b.x)], 1u);
            asm volatile("s_waitcnt vmcnt(0)" ::: "memory");
        } else {
            XB_SPIN(xb_ld(&bar[XB_XGEN(b.x)]) == gen, bar);
            __builtin_amdgcn_fence(__ATOMIC_ACQUIRE, "agent");
            asm volatile("s_waitcnt vmcnt(0)" ::: "memory");
        }
    }
    __syncthreads();
}

typedef pg8::bf16_t bf16_t; typedef pg8::bf16x8 bf16x8; typedef pg8::f32x4 f32x4; typedef pg8::u32x4 u32x4;
typedef unsigned u32x2 __attribute__((ext_vector_type(2)));
constexpr int NB = 2, SEQ = 4096, LEAD = 128, LL = 4224, NPAD = 112, R = NB * LL, DM = 4096;
constexpr int NPROJ = 9728, NIN = 9984, NSM = 256, DFF = 11008, NUP = 22016, NQ = 2304, NKV = 3072;
constexpr int GCH = 66, GUNITS = NB * 4 * GCH;
constexpr float EPS = 1e-6f;
constexpr int PC_FQ = 2048, PC_FK = 3584, PC_FV = 5120, PC_GQ = 6656, PC_GK = 7168, PC_GV = 7680, PC_GR = 8704;

constexpr size_t MiB = 1u << 20;
constexpr size_t al(size_t x) { return (x + MiB - 1) / MiB * MiB; }
constexpr size_t WS_CTL = 0, CTL_ZERO_BYTES = MiB;
constexpr size_t WS_CS = 1 * MiB;
constexpr size_t WS_W = 4 * MiB;
constexpr size_t SZ_WIN = (size_t)NIN * DM * 2, SZ_WUQ = (size_t)NQ * 1536 * 2, SZ_WUKV = (size_t)NKV * 512 * 2, SZ_WOUT = (size_t)DM * DM * 2, SZ_WUP = (size_t)NUP * DM * 2, SZ_WDN = (size_t)DM * DFF * 2;
constexpr size_t OFF_WIN = 0, OFF_WUQ = OFF_WIN + al(SZ_WIN), OFF_WUKV = OFF_WUQ + al(SZ_WUQ), OFF_WOUT = OFF_WUKV + al(SZ_WUKV), OFF_WUP = OFF_WOUT + al(SZ_WOUT), OFF_WDN = OFF_WUP + al(SZ_WUP), SZ_WLAYER = OFF_WDN + al(SZ_WDN);
constexpr size_t WS_H = WS_W + 2 * SZ_WLAYER;
constexpr size_t WS_HN = WS_H + al((size_t)R * DM * 4);
constexpr size_t WS_PROJ = WS_HN + al((size_t)R * DM * 2);
constexpr size_t WS_SMALL = WS_PROJ + al((size_t)R * NPROJ * 2);
constexpr size_t WS_CQN = WS_SMALL + al((size_t)R * NSM * 4);
constexpr size_t WS_CKVN = WS_CQN + al((size_t)R * 1536 * 2);
constexpr size_t WS_KPE = WS_CKVN + al((size_t)R * 512 * 2);
constexpr size_t WS_LOGA = WS_KPE + al((size_t)R * 64 * 2);
constexpr size_t WS_LOGF = WS_LOGA + al((size_t)R * 512 * 4);
constexpr size_t WS_CF = WS_LOGF + al((size_t)R * 16 * 4);
constexpr size_t WS_QM = WS_CF + al((size_t)NB * 12 * LL * 4);
constexpr size_t WS_KVM = WS_QM + al((size_t)R * NQ * 2);
constexpr size_t WS_OG = WS_KVM + al((size_t)R * NKV * 2);
constexpr size_t WS_UB = WS_OG + al((size_t)R * DM * 4);
constexpr size_t WS_DEC = WS_UB + al((size_t)GUNITS * 128 * 256 * 4);
constexpr size_t WS_QDG = WS_DEC + al((size_t)GUNITS * 128 * 4);
constexpr size_t WS_SPT = WS_QDG + al((size_t)R * 512 * 2);
constexpr size_t WS_MIX = WS_SPT + al((size_t)GUNITS * 256 * 128 * 2);
constexpr size_t WS_EDGE = WS_MIX + al((size_t)R * DM * 2);
constexpr size_t WS_UM = WS_EDGE + al((size_t)32 * 4 * NUP * 4);
constexpr size_t WS_ACT = WS_UM + al((size_t)16 * NUP * 4);
constexpr size_t WS_WQ = WS_ACT + al((size_t)R * DFF * 2);
constexpr size_t SZ_WQ = (size_t)NUP * DM;
constexpr size_t WS_HNQ = WS_WQ + al(2 * SZ_WQ);
constexpr size_t WS_ASC = WS_HNQ + al((size_t)R * DM);
constexpr size_t WS_WSC = WS_ASC + MiB;
constexpr size_t WS_KN2 = WS_WSC + MiB;
constexpr size_t WS_KPM = WS_KN2 + al((size_t)R * 16 * 4);
constexpr size_t WS_END = WS_KPM + MiB;
constexpr int CW_BAR = 4096;
static_assert((CW_BAR + XCD_BAR_WORDS) * 4 <= (int)CTL_ZERO_BYTES, "ctl");
constexpr size_t WS_WMAX = 262144;
static_assert(WS_WMAX + 2 * NUP * 4 <= CTL_ZERO_BYTES, "wmax");
constexpr size_t WS_SS0 = 524288, WS_SS1 = 655360;
static_assert(WS_SS0 >= WS_WMAX + 2 * NUP * 4 && WS_SS0 + (size_t)R * 8 <= WS_SS1 && WS_SS1 + (size_t)R * 8 <= CTL_ZERO_BYTES, "ss");
constexpr float SS_FIX = 4294967296.0f, SS_UNFIX = 1.0f / 4294967296.0f;
constexpr int RING_BYTES = 131072, MISC_OFF = RING_BYTES, LDS_BYTES = 147456;

__device__ __forceinline__ float bf2f(bf16_t b) { return __uint_as_float(((unsigned)b) << 16); }
__device__ __forceinline__ bf16_t f2bf(float f) { unsigned u = __float_as_uint(f); u += 0x7fffu + ((u >> 16) & 1u); return (bf16_t)(u >> 16); }
__device__ __forceinline__ unsigned pk2(float lo, float hi) { return (unsigned)f2bf(lo) | ((unsigned)f2bf(hi) << 16); }
__device__ __forceinline__ float wave_sum(float v) {
#pragma unroll
    for (int o = 1; o < 64; o <<= 1) v += __shfl_xor(v, o);
    return v;
}
__device__ __forceinline__ float logsig(float x) { return fminf(x, 0.f) - log1pf(expf(-fabsf(x))); }
#define LDS_WAIT() asm volatile("s_waitcnt lgkmcnt(0)" ::: "memory")

struct Args { const float* in[21]; float* out; unsigned char* ws; int ph_lo, ph_hi; };
#define WSP(T, off) ((T*)(a.ws + (off)))

__device__ __forceinline__ int map_in(int n) {
    if (n < 2048) return n;
    if (n < 3584) return 5200 + (n - 2048);
    if (n < 5120) return 6736 + (n - 3584);
    if (n < 6656) return 8272 + (n - 5120);
    if (n < 7168) return 2112 + (n - 6656);
    if (n < 7680) return 2624 + (n - 7168);
    if (n < 8704) return 3136 + (n - 7680);
    if (n < 9728) return 4176 + (n - 8704);
    if (n < 9792) { const int j = n - 9728; return 2048 + (j & 1) * 32 + (j >> 1); }
    if (n < 9808) return 4160 + (n - 9792);
    if (n < 9820) return n;
    return -1;
}
__device__ __forceinline__ int map_uq(int n) {
    if (n < 1536) return (n >> 7) * 192 + (n & 127);
    const int j = n - 1536, h = j >> 6, jj = j & 63; return h * 192 + 128 + (jj & 1) * 32 + (jj >> 1);
}
__device__ __forceinline__ int map_up(int n) { const int pn = n >> 8, w = n & 255; return w < 128 ? 128 * pn + w : DFF + 128 * pn + (w - 128); }
__device__ __forceinline__ int map_ukv(int n) {
    if (n < 1536) return (n >> 7) * 256 + (n & 127);
    const int j = n - 1536; return (j >> 7) * 256 + 128 + (j & 127);
}
template <int MAP, int GM>
__device__ __forceinline__ void prep_item(const float* W, int Nsrc, bf16_t* WT, int K, int Ndst, const float* g0, const float* g1, const float* g2, LAS float* scr, int item, int lane, const float wscale = 1.0f) {
    const int nblk = Ndst / 32, kb = item / nblk, nb = item % nblk, k0 = 128 * kb, n0 = 32 * nb;
    const int n = n0 + (lane & 31);
    const int src = MAP == 0 ? n : MAP == 1 ? map_in(n) : MAP == 2 ? map_uq(n) : MAP == 3 ? map_ukv(n) : map_up(n);
    float vv[64];
#pragma unroll
    for (int i = 0; i < 64; ++i) { const int k = k0 + 2 * i + (lane >> 5); vv[i] = src >= 0 ? W[(size_t)k * Nsrc + src] : 0.f; }
    const int c = lane & 7;
#pragma unroll
    for (int h = 0; h < 2; ++h) {
#pragma unroll
        for (int i = 0; i < 32; ++i) { const int kk = 2 * i + (lane >> 5), k = k0 + 64 * h + kk; float v = vv[32 * h + i];
            if (GM == 1) v *= g0[k] * wscale;
            if (GM == 2) v *= (k < 1536 ? g0[k] : k < 2560 ? g1[k - 1536] : g2[k - 2560]);
            scr[kk * 33 + (lane & 31)] = v; }
        LDS_WAIT(); asm volatile("" ::: "memory");
#pragma unroll
        for (int j = 0; j < 4; ++j) { const int nn = (lane >> 3) + 8 * j; const LAS float* s = scr + (8 * c) * 33 + nn;
            u32x4 o; o.x = pk2(s[0 * 33], s[1 * 33]); o.y = pk2(s[2 * 33], s[3 * 33]); o.z = pk2(s[4 * 33], s[5 * 33]); o.w = pk2(s[6 * 33], s[7 * 33]);
            *(u32x4*)(WT + (size_t)(n0 + nn) * K + k0 + 64 * h + 8 * c) = o; }
        LDS_WAIT(); asm volatile("" ::: "memory");
    }
}
__device__ const double INVF[32] = {1.0, 0.7498942093324559, 0.5623413251903491, 0.4216965034285822, 0.31622776601683794, 0.23713737056616552, 0.1778279410038923, 0.1333521432163324, 0.1, 0.07498942093324558, 0.05623413251903491, 0.042169650342858224, 0.03162277660168379, 0.023713737056616554, 0.01778279410038923, 0.01333521432163324, 0.01, 0.007498942093324558, 0.005623413251903491, 0.004216965034285823, 0.0031622776601683794, 0.0023713737056616554, 0.0017782794100389228, 0.001333521432163324, 0.001, 0.0007498942093324559, 0.0005623413251903491, 0.00042169650342858224, 0.00031622776601683794, 0.00023713737056616554, 0.00017782794100389227, 0.0001333521432163324};

__device__ __forceinline__ f32x4 bf4(unsigned lo, unsigned hi) { f32x4 r; r[0] = __uint_as_float(lo << 16); r[1] = __uint_as_float(lo & 0xffff0000u); r[2] = __uint_as_float(hi << 16); r[3] = __uint_as_float(hi & 0xffff0000u); return r; }
template <int MODE>
__device__ __forceinline__ void norm_rows(const Args& a, const float* gain, int gw, int NGW, int lane) {
    for (int row = gw; row < R; row += NGW) {
        const int b = row / LL, p = row - b * LL;
        if (MODE == 2 && p < LEAD) continue;
        f32x4 v[16];
        u32x4* hrow = (u32x4*)(WSP(bf16_t, WS_H) + (size_t)row * DM);
        if (MODE == 0) {
            const float* src = p < NPAD ? nullptr : p < LEAD ? a.in[1] + (size_t)(p - NPAD) * DM : a.in[0] + ((size_t)b * SEQ + (p - LEAD)) * DM;
#pragma unroll
            for (int j = 0; j < 16; ++j) v[j] = src ? *((const f32x4*)src + 128 * (j >> 1) + 2 * lane + (j & 1)) : (f32x4){0.f, 0.f, 0.f, 0.f};
#pragma unroll
            for (int j = 0; j < 8; ++j) { u32x4 w; w.x = pk2(v[2 * j].x, v[2 * j].y); w.y = pk2(v[2 * j].z, v[2 * j].w); w.z = pk2(v[2 * j + 1].x, v[2 * j + 1].y); w.w = pk2(v[2 * j + 1].z, v[2 * j + 1].w); hrow[64 * j + lane] = w; }
        } else {
            u32x4 q[8];
#pragma unroll
            for (int j = 0; j < 8; ++j) q[j] = hrow[64 * j + lane];
#pragma unroll
            for (int j = 0; j < 8; ++j) { v[2 * j] = bf4(q[j].x, q[j].y); v[2 * j + 1] = bf4(q[j].z, q[j].w); }
        }
        float ss = 0.f;
#pragma unroll
        for (int j = 0; j < 16; ++j) ss += (v[j].x * v[j].x + v[j].y * v[j].y) + (v[j].z * v[j].z + v[j].w * v[j].w);
        const float sst = wave_sum(ss);
        if (MODE == 0) { if (lane == 0) ((unsigned long long*)(a.ws + WS_SS0))[row] = (unsigned long long)(sst * SS_FIX); continue; }
        const float rs = 1.0f / sqrtf(sst * (1.0f / DM) + EPS);
        if (MODE == 3) {
            float am = 0.f;
#pragma unroll
            for (int j = 0; j < 16; ++j) am = fmaxf(fmaxf(am, fmaxf(fabsf(v[j].x), fabsf(v[j].y))), fmaxf(fabsf(v[j].z), fabsf(v[j].w)));
#pragma unroll
            for (int o = 1; o < 64; o <<= 1) am = fmaxf(am, __shfl_xor(am, o));
            const float qi = am > 0.f ? 127.0f / am : 0.f;
            u32x2* oq = (u32x2*)(a.ws + WS_HNQ + (size_t)row * DM);
#pragma unroll
            for (int j = 0; j < 8; ++j) { u32x2 w;
#pragma unroll
                for (int h = 0; h < 2; ++h) { const f32x4 x = v[2 * j + h]; const int q0 = (int)rintf(x.x * qi), q1 = (int)rintf(x.y * qi), q2 = (int)rintf(x.z * qi), q3 = (int)rintf(x.w * qi);
                    w[h] = (unsigned)(q0 & 255) | ((unsigned)(q1 & 255) << 8) | ((unsigned)(q2 & 255) << 16) | ((unsigned)(q3 & 255) << 24); }
                oq[64 * j + lane] = w; }
            if (lane == 0) WSP(float, WS_ASC)[row] = rs * am * (1.0f / 127.0f);
            if (p >= NPAD && p < LEAD) { u32x4* o = (u32x4*)(WSP(bf16_t, WS_HN) + (size_t)row * DM);
#pragma unroll
                for (int j = 0; j < 8; ++j) { u32x4 w; w.x = pk2(v[2 * j].x * rs, v[2 * j].y * rs); w.y = pk2(v[2 * j].z * rs, v[2 * j].w * rs); w.z = pk2(v[2 * j + 1].x * rs, v[2 * j + 1].y * rs); w.w = pk2(v[2 * j + 1].z * rs, v[2 * j + 1].w * rs); o[64 * j + lane] = w; } }
        } else if (MODE == 2) {
            float* o = a.out + ((size_t)b * SEQ + (p - LEAD)) * DM;
#pragma unroll
            for (int j = 0; j < 16; ++j) { const int idx = 128 * (j >> 1) + 2 * lane + (j & 1); const f32x4 g = *((const f32x4*)gain + idx); *((f32x4*)o + idx) = v[j] * rs * g; }
        } else {
            u32x4* o = (u32x4*)(WSP(bf16_t, WS_HN) + (size_t)row * DM);
#pragma unroll
            for (int j = 0; j < 8; ++j) { u32x4 w; w.x = pk2(v[2 * j].x * rs, v[2 * j].y * rs); w.y = pk2(v[2 * j].z * rs, v[2 * j].w * rs); w.z = pk2(v[2 * j + 1].x * rs, v[2 * j + 1].y * rs); w.w = pk2(v[2 * j + 1].z * rs, v[2 * j + 1].w * rs); o[64 * j + lane] = w; }
        }
    }
}

__device__ __forceinline__ void prep_wup_strip(const Args& a, LAS unsigned char* lds, int strip, int tid, const int wave_s) {
    const int l = strip / (NUP / 32), n0 = (strip % (NUP / 32)) * 32;
    { int t0; asm volatile("v_mbcnt_lo_u32_b32 %0, -1, 0\n\tv_mbcnt_hi_u32_b32 %0, -1, %0" : "=v"(t0)); tid = t0 + wave_s * 64; }
    const int col = tid & 31, rg = tid >> 5;
    const char* Wu = (const char*)(a.in[16] + (size_t)l * DM * NUP);
    const unsigned loff = (unsigned)(map_up(n0 + col) + 4 * rg * NUP) * 4u;
    LAS float* GL = (LAS float*)lds;
    LAS float* RED = (LAS float*)(lds + 16384);
    LAS unsigned* T = (LAS unsigned*)(lds + 16384 + 2048);
    __syncthreads();
    for (int i = tid; i < DM / 4; i += 512) ((LAS f32x4*)GL)[i] = ((const f32x4*)(a.in[15] + (size_t)l * DM))[i];
    __syncthreads();
    unsigned pk[64][2];
    float amax = 0.f;
#pragma unroll
    for (int i0 = 0; i0 < 64; i0 += 8) {
        float v[32];
#pragma unroll
        for (int j = 0; j < 32; ++j) v[j] = *(const float*)(Wu + (size_t)(64 * (i0 + (j >> 2)) + (j & 3)) * NUP * 4 + loff);
#pragma unroll
        for (int j4 = 0; j4 < 8; ++j4) { const f32x4 gg = *(const LAS f32x4*)(GL + 64 * (i0 + j4) + 4 * rg);
            const unsigned w0 = pk2(v[4 * j4] * gg[0], v[4 * j4 + 1] * gg[1]), w1 = pk2(v[4 * j4 + 2] * gg[2], v[4 * j4 + 3] * gg[3]);
            { unsigned o0 = w0, o1 = w1; asm volatile("" : "+v"(o0), "+v"(o1)); pk[i0 + j4][0] = o0; pk[i0 + j4][1] = o1; }
            amax = fmaxf(fmaxf(amax, fmaxf(fabsf(__uint_as_float(w0 << 16)), fabsf(__uint_as_float(w0 & 0xffff0000u)))), fmaxf(fabsf(__uint_as_float(w1 << 16)), fabsf(__uint_as_float(w1 & 0xffff0000u)))); }
        asm volatile("" ::: "memory");
    }
    int tq; asm volatile("v_mbcnt_lo_u32_b32 %0, -1, 0\n\tv_mbcnt_hi_u32_b32 %0, -1, %0" : "=v"(tq)); tq += wave_s * 64;
    const int col2 = tq & 31, rg2 = tq >> 5;
    RED[rg2 * 32 + col2] = amax;
    __syncthreads();
    float am = 0.f;
#pragma unroll
    for (int r = 0; r < 16; ++r) am = fmaxf(am, RED[r * 32 + col2]);
    const float qi = am > 0.f ? 127.0f / am : 0.f;
    if (rg2 == 0) WSP(float, WS_WSC)[(size_t)l * NUP + n0 + col2] = am * (1.0f / 127.0f);
    char* WQ = (char*)(a.ws + WS_WQ + (size_t)l * SZ_WQ + (size_t)n0 * DM);
    const unsigned woff = (unsigned)((tq >> 4) * DM + 16 * (tq & 15)), tw = (unsigned)(col2 * 65 + rg2), tr = (unsigned)((tq >> 4) * 65 + 4 * (tq & 15));
#pragma unroll
    for (int c = 0; c < 16; ++c) {
        LAS unsigned* Tb = T + (c & 1) * (32 * 65);
#pragma unroll
        for (int ii = 0; ii < 4; ++ii) { const unsigned w0 = pk[4 * c + ii][0], w1 = pk[4 * c + ii][1];
            const int q0 = (int)rintf(__uint_as_float(w0 << 16) * qi), q1 = (int)rintf(__uint_as_float(w0 & 0xffff0000u) * qi), q2 = (int)rintf(__uint_as_float(w1 << 16) * qi), q3 = (int)rintf(__uint_as_float(w1 & 0xffff0000u) * qi);
            Tb[tw + 16 * ii] = (unsigned)(q0 & 255) | ((unsigned)(q1 & 255) << 8) | ((unsigned)(q2 & 255) << 16) | ((unsigned)(q3 & 255) << 24); }
        __syncthreads();
        { const LAS unsigned* s = Tb + tr; u32x4 w; w.x = s[0]; w.y = s[1]; w.z = s[2]; w.w = s[3];
          *(u32x4*)(WQ + woff + 256 * c) = w; }
    }
}
__device__ __forceinline__ void phase_prologue(const Args& a, LAS unsigned char* lds, int tid, int lane, int wave) {
    LAS float* scr = (LAS float*)(lds + wave * 16384);
    const int gw = blockIdx.x * 8 + wave, NGW = gridDim.x * 8;
    constexpr int I_IN = (DM / 128) * (NIN / 32), I_UQ = (1536 / 128) * (NQ / 32), I_UKV = (512 / 128) * (NKV / 32), I_OUT = (DM / 128) * (DM / 32), I_DN = (DFF / 128) * (DM / 32);
    static_assert(DFF % 128 == 0 && 1536 % 128 == 0, "item k extent");
    constexpr int I_LAYER = I_IN + I_UQ + I_UKV + I_OUT + I_DN;
    for (int it = gw; it < 2 * I_LAYER; it += NGW) {
        const int l = it / I_LAYER; int r = it - l * I_LAYER;
        unsigned char* wb = a.ws + WS_W + (size_t)l * SZ_WLAYER;
        if (r < I_IN) { prep_item<1, 1>(a.in[3] + (size_t)l * DM * 9820, 9820, (bf16_t*)(wb + OFF_WIN), DM, NIN, a.in[2] + l * DM, nullptr, nullptr, scr, r, lane); continue; } r -= I_IN;
        if (r < I_UQ) { prep_item<2, 1>(a.in[5] + (size_t)l * 1536 * 2304, 2304, (bf16_t*)(wb + OFF_WUQ), 1536, NQ, a.in[4] + l * 1536, nullptr, nullptr, scr, r, lane, 0.07216878364870322f * 1.4426950408889634f); continue; } r -= I_UQ;
        if (r < I_UKV) { prep_item<3, 1>(a.in[7] + (size_t)l * 512 * 3072, 3072, (bf16_t*)(wb + OFF_WUKV), 512, NKV, a.in[6] + l * 512, nullptr, nullptr, scr, r, lane); continue; } r -= I_UKV;
        if (r < I_OUT) { prep_item<0, 2>(a.in[14] + (size_t)l * DM * DM, DM, (bf16_t*)(wb + OFF_WOUT), DM, DM, a.in[11] + l * 1536, a.in[12] + l * 1024, a.in[13] + l * 1536, scr, r, lane); continue; } r -= I_OUT;
        prep_item<0, 0>(a.in[19] + (size_t)l * DFF * DM, DM, (bf16_t*)(wb + OFF_WDN), DFF, DM, nullptr, nullptr, nullptr, scr, r, lane);
    }
    for (int e = blockIdx.x * 512 + tid; e < LL * 32; e += gridDim.x * 512) {
        const int p = e >> 5, i = e & 31; const int pos = p > NPAD ? p - NPAD : 0;
        const double ang = (double)pos * INVF[i]; const double kr = rint(ang * 0.15915494309189535); const float rr = (float)(ang - kr * 6.283185307179586);
        WSP(float, WS_CS)[2 * e] = cosf(rr); WSP(float, WS_CS)[2 * e + 1] = sinf(rr);
    }
    norm_rows<0>(a, nullptr, gw, NGW, lane);
}

__device__ __forceinline__ void phase_wquant(const Args& a, int layer, int gw, int NGW, int lane) {
    const bf16_t* Wt = (const bf16_t*)(a.ws + WS_W + (size_t)layer * SZ_WLAYER + OFF_WUP); const float* wmax = (const float*)(a.ws + WS_WMAX) + (size_t)layer * NUP;
    unsigned char* WQ = a.ws + WS_WQ + (size_t)layer * SZ_WQ; float* wsc = WSP(float, WS_WSC) + (size_t)layer * NUP;
    for (int n = gw; n < NUP; n += NGW) {
        const float am = wmax[n], qi = am > 0.f ? 127.0f / am : 0.f;
        if (lane == 0) wsc[n] = am * (1.0f / 127.0f);
#pragma unroll
        for (int j = 0; j < 8; ++j) { const int c = lane + 64 * j; const bf16x8 raw = *(const bf16x8*)(Wt + (size_t)n * DM + c * 8); unsigned w0 = 0u, w1 = 0u;
#pragma unroll
            for (int e = 0; e < 4; ++e) { const int q = (int)rintf(bf2f((bf16_t)raw[e]) * qi); w0 |= (unsigned)(q & 255) << (8 * e); }
#pragma unroll
            for (int e = 0; e < 4; ++e) { const int q = (int)rintf(bf2f((bf16_t)raw[4 + e]) * qi); w1 |= (unsigned)(q & 255) << (8 * e); }
            u32x2 w; w.x = w0; w.y = w1; *(u32x2*)(WQ + (size_t)n * DM + c * 8) = w; }
    }
}

__device__ __forceinline__ void phase_prep_rows(const Args& a, int layer, int gw, int NGW, int lane_in) {
    const float* W2 = a.in[8] + (size_t)layer * 16 * 512; const float* bG = a.in[9] + layer * 512; const float* bF = a.in[10] + layer * 12;
    for (int row = gw; row < R; row += NGW) {
        const int p = row % LL; const bool valid = p >= NPAD;
        int lane = lane_in; asm volatile("" : "+v"(lane));
        const bf16_t* pr = WSP(bf16_t, WS_PROJ) + (size_t)row * NPROJ;
        const float* sm = WSP(float, WS_SMALL) + (size_t)row * NSM;
        bf16x8 rq[3], rk[3];
#pragma unroll
        for (int j = 0; j < 3; ++j) rq[j] = *(const bf16x8*)(pr + (lane + 64 * j) * 8);
        const bf16x8 rkv = *(const bf16x8*)(pr + 1536 + lane * 8);
#pragma unroll
        for (int j = 0; j < 3; ++j) rk[j] = *(const bf16x8*)(pr + PC_FK + (lane + 64 * j) * 8);
        const int l32 = lane & 31;
        const float x1 = sm[2 * l32], x2 = sm[2 * l32 + 1], cc = WSP(float, WS_CS)[((size_t)p * 32 + l32) * 2], sn = WSP(float, WS_CS)[((size_t)p * 32 + l32) * 2 + 1];
        f32x4 gzv[4];
#pragma unroll
        for (int j = 0; j < 4; ++j) gzv[j] = *(const f32x4*)(sm + 64 + 4 * j);
        const float zf = sm[80 + (lane < 12 ? lane : 0)] + bF[lane < 12 ? lane : 0];
        u32x4 wq[3];
        { float x[3][8]; float ss = 0.f;
#pragma unroll
            for (int j = 0; j < 3; ++j)
#pragma unroll
                for (int e = 0; e < 8; ++e) { x[j][e] = bf2f((bf16_t)rq[j][e]); ss += x[j][e] * x[j][e]; }
            const float rs = 1.0f / sqrtf(wave_sum(ss) * (1.0f / 1536.f) + EPS);
#pragma unroll
            for (int j = 0; j < 3; ++j) { wq[j].x = pk2(x[j][0] * rs, x[j][1] * rs); wq[j].y = pk2(x[j][2] * rs, x[j][3] * rs); wq[j].z = pk2(x[j][4] * rs, x[j][5] * rs); wq[j].w = pk2(x[j][6] * rs, x[j][7] * rs); } }
        u32x4 wkv;
        { float x[8]; float ss = 0.f;
#pragma unroll
            for (int e = 0; e < 8; ++e) { x[e] = bf2f((bf16_t)rkv[e]); ss += x[e] * x[e]; }
            const float rs = 1.0f / sqrtf(wave_sum(ss) * (1.0f / 512.f) + EPS);
            wkv.x = pk2(x[0] * rs, x[1] * rs); wkv.y = pk2(x[2] * rs, x[3] * rs); wkv.z = pk2(x[4] * rs, x[5] * rs); wkv.w = pk2(x[6] * rs, x[7] * rs); }
        const unsigned kpe = pk2(x1 * cc - x2 * sn, x2 * cc + x1 * sn);
        f32x4 o0, o1;
        { float acc[8];
            { const f32x4 b0 = *(const f32x4*)(bG + lane * 8), b1 = *(const f32x4*)(bG + lane * 8 + 4); acc[0] = b0.x; acc[1] = b0.y; acc[2] = b0.z; acc[3] = b0.w; acc[4] = b1.x; acc[5] = b1.y; acc[6] = b1.z; acc[7] = b1.w; }
#pragma unroll
            for (int j = 0; j < 16; ++j) { if ((j & 3) == 0) asm volatile("" ::: "memory");
                const float gz = gzv[j >> 2][j & 3]; const f32x4 w0 = *(const f32x4*)(W2 + j * 512 + lane * 8), w1 = *(const f32x4*)(W2 + j * 512 + lane * 8 + 4);
                acc[0] += gz * w0.x; acc[1] += gz * w0.y; acc[2] += gz * w0.z; acc[3] += gz * w0.w; acc[4] += gz * w1.x; acc[5] += gz * w1.y; acc[6] += gz * w1.z; acc[7] += gz * w1.w; }
            o0.x = valid ? logsig(acc[0]) * 0.0625f : 0.f; o0.y = valid ? logsig(acc[1]) * 0.0625f : 0.f; o0.z = valid ? logsig(acc[2]) * 0.0625f : 0.f; o0.w = valid ? logsig(acc[3]) * 0.0625f : 0.f;
            o1.x = valid ? logsig(acc[4]) * 0.0625f : 0.f; o1.y = valid ? logsig(acc[5]) * 0.0625f : 0.f; o1.z = valid ? logsig(acc[6]) * 0.0625f : 0.f; o1.w = valid ? logsig(acc[7]) * 0.0625f : 0.f; }
        const float lf = valid ? logsig(zf) : 0.f;
        float kn[3];
#pragma unroll
        for (int j = 0; j < 3; ++j) { float ss = 0.f;
#pragma unroll
            for (int e = 0; e < 8; ++e) { const float x = bf2f((bf16_t)rk[j][e]); ss += x * x; }
            ss += __shfl_xor(ss, 1); ss += __shfl_xor(ss, 2); ss += __shfl_xor(ss, 4); ss += __shfl_xor(ss, 8); kn[j] = ss; }
#pragma unroll
        for (int j = 0; j < 3; ++j) *(u32x4*)(WSP(bf16_t, WS_CQN) + (size_t)row * 1536 + (lane + 64 * j) * 8) = wq[j];
        *(u32x4*)(WSP(bf16_t, WS_CKVN) + (size_t)row * 512 + lane * 8) = wkv;
        if (lane < 32) *(unsigned*)(WSP(bf16_t, WS_KPE) + (size_t)row * 64 + 2 * lane) = kpe;
        *(f32x4*)(WSP(float, WS_LOGA) + (size_t)row * 512 + lane * 8) = o0; *(f32x4*)(WSP(float, WS_LOGA) + (size_t)row * 512 + lane * 8 + 4) = o1;
        if (lane < 12) WSP(float, WS_LOGF)[(size_t)row * 16 + lane] = lf;
        if ((lane & 15) == 0) {
#pragma unroll
            for (int j = 0; j < 3; ++j) WSP(float, WS_KN2)[(size_t)row * 16 + 4 * j + (lane >> 4)] = kn[j]; }
    }
}
__device__ __forceinline__ void phase_fcum(const Args& a, int gw, int lane) {
    const int G = gridDim.x; int seq;
    if (G >= 128) { if ((gw & 7) != 0 || (gw >> 3) < 96 || (gw >> 3) >= 96 + NB * 12) return; seq = (gw >> 3) - 96; }
    else { if (gw >= NB * 12) return; seq = gw; }
    const int b = seq / 12, h = seq % 12; constexpr int PER = LL / 64;
    const float* src = WSP(float, WS_LOGF) + ((size_t)b * LL + lane * PER) * 16 + h;
    float v[PER]; float s = 0.f;
#pragma unroll
    for (int i = 0; i < PER; ++i) v[i] = src[(size_t)i * 16];
#pragma unroll
    for (int i = 0; i < PER; ++i) s += v[i];
    float incl = s;
#pragma unroll
    for (int o = 1; o < 64; o <<= 1) { const float t = __shfl_up(incl, o); if (lane >= o) incl += t; }
    float run = incl - s;
    float* dst = WSP(float, WS_CF) + ((size_t)b * 12 + h) * LL + lane * PER;
#pragma unroll
    for (int i = 0; i < PER; ++i) { run += v[i]; dst[i] = run; }
#pragma unroll
    for (int t = 0; t < PER; ++t) { const int p = 64 * t + lane; v[t] = p >= NPAD ? WSP(const float, WS_KN2)[((size_t)b * LL + p) * 16 + h] : 0.f; }
    float pm = 0.f;
#pragma unroll
    for (int t = 0; t < PER; ++t) { float x = v[t];
#pragma unroll
        for (int o = 1; o < 64; o <<= 1) x = fmaxf(x, __shfl_xor(x, o));
        pm = fmaxf(pm, x); if (lane == 0) WSP(float, WS_KPM)[(size_t)seq * PER + t] = sqrtf(pm); }
}

__device__ __forceinline__ f32x4 mma16(const LAS bf16_t* A, int lda, const LAS bf16_t* Bt, int ldb, int K, int lane, f32x4 acc) {
    const LAS bf16_t* a = A + (lane & 15) * lda + 8 * (lane >> 4);
    const LAS bf16_t* b = Bt + (lane & 15) * ldb + 8 * (lane >> 4);
    for (int k0 = 0; k0 < K; k0 += 32) acc = __builtin_amdgcn_mfma_f32_16x16x32_bf16(*(const LAS bf16x8*)(a + k0), *(const LAS bf16x8*)(b + k0), acc, 0, 0, 0);
    return acc;
}

struct SkEmit { int mode; bf16_t* O; int ldo; int nbf_cols; float* F; int ldf; int rope_from; const float* cs; bf16_t* H; const unsigned long long* rss; unsigned long long* ssq; };
__device__ __forceinline__ void sk_emit(const SkEmit& e, int r, int col, float v, int lane) {
    if (e.mode == 3) { e.F[(size_t)r * e.ldf + col] = v; return; }
    if (e.mode == 2) { bf16_t* p0 = e.H + (size_t)(NPAD + r) * DM + col; const bf16_t nv = f2bf(bf2f(*p0) + v); *p0 = nv; p0[(size_t)LL * DM] = nv;
        if (e.ssq) { float s2 = bf2f(nv) * bf2f(nv); s2 += __shfl_xor(s2, 1); s2 += __shfl_xor(s2, 2); s2 += __shfl_xor(s2, 4); s2 += __shfl_xor(s2, 8);
            if ((lane & 15) == 0) { const unsigned long long q = (unsigned long long)(s2 * SS_FIX); atomicAdd(e.ssq + NPAD + r, q); atomicAdd(e.ssq + LL + NPAD + r, q); } }
        return; }
    if (e.rss) v *= 1.0f / sqrtf((float)e.rss[NPAD + r] * (SS_UNFIX / DM) + EPS);
    if (col >= e.rope_from) { const float o = __shfl_xor(v, 1); const int i = (col & 63) >> 1; const float* t = e.cs + ((size_t)(NPAD + r) * 32 + i) * 2; const float c = t[0], s = t[1];
        v = (lane & 1) ? (v * c + o * s) : (v * c - o * s); }
    if (col < e.nbf_cols) { const bf16_t w = f2bf(v); bf16_t* p0 = e.O + (size_t)(NPAD + r) * e.ldo + col; *p0 = w; p0[(size_t)LL * e.ldo] = w; }
    else { float* p0 = e.F + (size_t)(NPAD + r) * e.ldf + (col - e.nbf_cols); *p0 = v; p0[(size_t)LL * e.ldf] = v; }
}
__device__ __forceinline__ void skinny_gemm(const bf16_t* A, const bf16_t* Wt, int N, int K, int nunits, const SkEmit& e, LAS unsigned char* lds, int lane, int wave) {
    const int G = gridDim.x, rem = nunits % G;
    const int first = ((int)blockIdx.x - rem + G) % G;
    const int ql = lane & 15, quad = lane >> 4, kw = K >> 3, nsteps = kw >> 5;
    LAS f32x4* red = (LAS f32x4*)lds;
    const bf16_t* ap = A + (size_t)(NPAD + ql) * K + wave * kw + 8 * quad;
    for (int ct = first; ct < (N >> 4); ct += G) {
        const bf16_t* bp = Wt + (size_t)(16 * ct + ql) * K + wave * kw + 8 * quad;
        f32x4 acc = {0.f, 0.f, 0.f, 0.f};
        for (int s0 = 0; s0 < nsteps; s0 += 16) {
            bf16x8 af[16], bf[16];
#pragma unroll
            for (int s = 0; s < 16; ++s) if (s0 + s < nsteps) { af[s] = *(const bf16x8*)(ap + (s0 + s) * 32); bf[s] = *(const bf16x8*)(bp + (s0 + s) * 32); }
#pragma unroll
            for (int s = 0; s < 16; ++s) if (s0 + s < nsteps) acc = __builtin_amdgcn_mfma_f32_16x16x32_bf16(af[s], bf[s], acc, 0, 0, 0);
        }
        red[wave * 64 + lane] = acc;
        __syncthreads();
        if (wave == 0) {
            f32x4 s = red[lane];
#pragma unroll
            for (int w = 1; w < 8; ++w) s = s + red[w * 64 + lane];
#pragma unroll
            for (int reg = 0; reg < 4; ++reg) sk_emit(e, quad * 4 + reg, 16 * ct + ql, s[reg], lane);
        }
        __syncthreads();
    }
}

__device__ __forceinline__ void skinny_gemm_i8(const unsigned char* Aq, const unsigned char* Wq, int N, int nunits, const float* asc, const float* wsc, const SkEmit& e, LAS unsigned char* lds, int lane, int wave) {
    typedef int i32x4_t __attribute__((ext_vector_type(4)));
    const int G = gridDim.x, rem = nunits % G;
    const int first = ((int)blockIdx.x - rem + G) % G;
    const int ql = lane & 15, quad = lane >> 4;
    LAS f32x4* red = (LAS f32x4*)lds;
    if (first >= (N >> 4)) return;
    const unsigned char* ap = Aq + (size_t)(NPAD + ql) * DM + wave * (DM / 8) + 16 * quad;
    for (int ct = first; ct < (N >> 4); ct += G) {
        const unsigned char* bp = Wq + (size_t)(16 * ct + ql) * DM + wave * (DM / 8) + 16 * quad;
        i32x4_t av[8], bv[8], acc = {0, 0, 0, 0};
#pragma unroll
        for (int s = 0; s < 8; ++s) { av[s] = *(const i32x4_t*)(ap + 64 * s); bv[s] = *(const i32x4_t*)(bp + 64 * s); }
#pragma unroll
        for (int s = 0; s < 8; ++s) acc = __builtin_amdgcn_mfma_i32_16x16x64_i8(av[s], bv[s], acc, 0, 0, 0);
        f32x4 f; f[0] = (float)acc[0]; f[1] = (float)acc[1]; f[2] = (float)acc[2]; f[3] = (float)acc[3];
        red[wave * 64 + lane] = f;
        __syncthreads();
        if (wave == 0) {
            f32x4 s = red[lane];
#pragma unroll
            for (int w = 1; w < 8; ++w) s = s + red[w * 64 + lane];
            const float cs_ = wsc[16 * ct + ql];
#pragma unroll
            for (int reg = 0; reg < 4; ++reg) sk_emit(e, quad * 4 + reg, 16 * ct + ql, s[reg] * cs_ * asc[NPAD + quad * 4 + reg], lane);
        }
        __syncthreads();
    }
}

__device__ __forceinline__ void phase_gla_b1(const Args& a, LAS unsigned char* lds, int tid, int lane, int wave) {
    LAS float* LA = (LAS float*)lds;
    LAS bf16_t* AM = (LAS bf16_t*)lds;
    LAS bf16_t* QD = (LAS bf16_t*)(lds + 32768);
    LAS bf16_t* KD = (LAS bf16_t*)(lds + 32768 + 17408);
    LAS bf16_t* KST = (LAS bf16_t*)(lds + 32768 + 2 * 17408);
    LAS bf16_t* VT = (LAS bf16_t*)(lds + 32768 + 2 * 17408 + 18432);
    const f32x4 zero = {0.f, 0.f, 0.f, 0.f};
    for (int u = (int)(gridDim.x - 1 - blockIdx.x); u < GUNITS; u += gridDim.x) {
        const int b = u / (4 * GCH), h = (u / GCH) & 3, n = u % GCH; const int r0 = b * LL + 64 * n;
        f32x4 la[4]; bf16x8 qraw_[2], kraw_[2], vraw_[4];
#pragma unroll
        for (int i = 0; i < 4; ++i) { const int idx = tid + 512 * i, t = idx >> 5, k4 = (idx & 31) * 4; la[i] = *(const f32x4*)(WSP(float, WS_LOGA) + (size_t)(r0 + t) * 512 + h * 128 + k4); }
#pragma unroll
        for (int i = 0; i < 2; ++i) { const int idx = tid + 512 * i, t = idx >> 4, k0 = (idx & 15) * 8; const size_t pr = (size_t)(r0 + t) * NPROJ;
            qraw_[i] = *(const bf16x8*)(WSP(const bf16_t, WS_PROJ) + pr + PC_GQ + h * 128 + k0); kraw_[i] = *(const bf16x8*)(WSP(const bf16_t, WS_PROJ) + pr + PC_GK + h * 128 + k0); }
#pragma unroll
        for (int i = 0; i < 4; ++i) { const int idx = tid + 512 * i, t = idx >> 5, j0 = (idx & 31) * 8; vraw_[i] = *(const bf16x8*)(WSP(const bf16_t, WS_PROJ) + (size_t)(r0 + t) * NPROJ + PC_GV + h * 256 + j0); }
#pragma unroll
        for (int i = 0; i < 4; ++i) { const int idx = tid + 512 * i, t = idx >> 5, k4 = (idx & 31) * 4; *(LAS f32x4*)(LA + t * 128 + k4) = la[i]; }
        __syncthreads();
        {
            const int k = tid & 127, part = tid >> 7; float v[16]; float run = 0.f;
#pragma unroll
            for (int i = 0; i < 16; ++i) { run += LA[(16 * part + i) * 128 + k]; v[i] = run; }
#pragma unroll
            for (int i = 0; i < 16; ++i) LA[(16 * part + i) * 128 + k] = v[i];
            __syncthreads();
            float off = 0.f;
#pragma unroll
            for (int p = 0; p < 3; ++p) if (p < part) off += LA[(16 * p + 15) * 128 + k];
            __syncthreads();
#pragma unroll
            for (int i = 0; i < 16; ++i) LA[(16 * part + i) * 128 + k] = v[i] + off;
        }
        __syncthreads();
#pragma unroll
        for (int i = 0; i < 2; ++i) { const int idx = tid + 512 * i, t = idx >> 4, k0 = (idx & 15) * 8;
            const bool vf = (64 * n + t) >= NPAD;
            const bf16x8 qraw = qraw_[i], kraw = kraw_[i];
            const f32x4 b0 = *(const LAS f32x4*)(LA + t * 128 + k0), b1 = *(const LAS f32x4*)(LA + t * 128 + k0 + 4), l0 = *(const LAS f32x4*)(LA + 63 * 128 + k0), l1 = *(const LAS f32x4*)(LA + 63 * 128 + k0 + 4);
            float qd[8], kd[8];
#pragma unroll
            for (int e = 0; e < 8; ++e) { const float bb = e < 4 ? b0[e & 3] : b1[e & 3], bl = e < 4 ? l0[e & 3] : l1[e & 3];
                const float q = bf2f((bf16_t)qraw[e]) * 0.08838834764831845f, kk = vf ? bf2f((bf16_t)kraw[e]) : 0.f;
                qd[e] = q * __expf(bb); kd[e] = kk * __expf(-bb); KST[(k0 + e) * 72 + t] = f2bf(kk * __expf(bl - bb)); }
            u32x4 wq, wk; wq.x = pk2(qd[0], qd[1]); wq.y = pk2(qd[2], qd[3]); wq.z = pk2(qd[4], qd[5]); wq.w = pk2(qd[6], qd[7]); wk.x = pk2(kd[0], kd[1]); wk.y = pk2(kd[2], kd[3]); wk.z = pk2(kd[4], kd[5]); wk.w = pk2(kd[6], kd[7]);
            *(LAS u32x4*)(QD + t * 136 + k0) = wq; *(LAS u32x4*)(KD + t * 136 + k0) = wk;
            *(u32x4*)(WSP(bf16_t, WS_QDG) + (size_t)(r0 + t) * 512 + h * 128 + k0) = wq;
            if (t == 63) { f32x4 d0, d1; d0[0] = __expf(l0[0]); d0[1] = __expf(l0[1]); d0[2] = __expf(l0[2]); d0[3] = __expf(l0[3]); d1[0] = __expf(l1[0]); d1[1] = __expf(l1[1]); d1[2] = __expf(l1[2]); d1[3] = __expf(l1[3]);
                *(f32x4*)(WSP(float, WS_DEC) + (size_t)u * 128 + k0) = d0; *(f32x4*)(WSP(float, WS_DEC) + (size_t)u * 128 + k0 + 4) = d1; } }
#pragma unroll
        for (int i = 0; i < 4; ++i) { const int idx = tid + 512 * i, t = idx >> 5, j0 = (idx & 31) * 8; const bf16x8 raw = vraw_[i];
#pragma unroll
            for (int e = 0; e < 8; ++e) VT[(j0 + e) * 72 + t] = (bf16_t)raw[e]; }
        __syncthreads();
        f32x4 a2[2];
#pragma unroll
        for (int q = 0; q < 2; ++q) { const int id = wave * 2 + q, tm = id >> 2, tn = id & 3; a2[q] = mma16(QD + 16 * tm * 136, 136, KD + 16 * tn * 136, 136, 128, lane, zero); }
#pragma unroll
        for (int q = 0; q < 2; ++q) { const int id = wave * 2 + q, tm = id >> 2, tn = id & 3;
#pragma unroll
            for (int reg = 0; reg < 4; ++reg) { const int t = 16 * tm + (lane >> 4) * 4 + reg, s = 16 * tn + (lane & 15); AM[t * 72 + s] = f2bf(s <= t ? a2[q][reg] : 0.f); } }
        __syncthreads();
#pragma unroll 2
        for (int q = 0; q < 8; ++q) { const int id = wave * 8 + q, tm = id >> 4, tn = id & 15; const f32x4 o = mma16(VT + 16 * tn * 72, 72, AM + 16 * tm * 72, 72, 64, lane, zero);
            u32x2 w; w.x = pk2(o[0], o[1]); w.y = pk2(o[2], o[3]); *(u32x2*)(WSP(bf16_t, WS_OG) + (size_t)(r0 + 16 * tm + (lane & 15)) * 1024 + h * 256 + 16 * tn + (lane >> 4) * 4) = w; }
#pragma unroll 2
        for (int q = 0; q < 16; ++q) { const int id = wave * 16 + q, tm = id >> 4, tn = id & 15; const f32x4 o = mma16(KST + 16 * tm * 72, 72, VT + 16 * tn * 72, 72, 64, lane, zero);
            u32x2 w; w.x = pk2(o[0], o[1]); w.y = pk2(o[2], o[3]); *(u32x2*)(WSP(bf16_t, WS_UB) + ((size_t)u * 256 + 16 * tn + (lane & 15)) * 128 + 16 * tm + (lane >> 4) * 4) = w; }
        __syncthreads();
    }
}
__device__ __forceinline__ void phase_gla_b2(const Args& a, int tid) {
    const bf16_t* __restrict__ UB = WSP(const bf16_t, WS_UB); const float* __restrict__ DEC = WSP(const float, WS_DEC); bf16_t* __restrict__ SPT = WSP(bf16_t, WS_SPT);
    for (int gid = blockIdx.x * 512 + tid; gid < NB * 4 * 256 * 32; gid += gridDim.x * 512) {
        const int bh = gid >> 13, j = (gid >> 5) & 255, kg = gid & 31; float S0 = 0.f, S1 = 0.f, S2 = 0.f, S3 = 0.f;
#pragma unroll 22
        for (int n = 0; n < GCH; ++n) { const size_t u = (size_t)bh * GCH + n; const size_t o = (u * 256 + j) * 128 + kg * 4; const f32x4 d = *(const f32x4*)(DEC + u * 128 + kg * 4);
            const u32x2 x = *(const u32x2*)(UB + o);
            u32x2 w; w.x = pk2(S0, S1); w.y = pk2(S2, S3); *(u32x2*)(SPT + o) = w;
            S0 = S0 * d.x + __uint_as_float(x.x << 16); S1 = S1 * d.y + __uint_as_float(x.x & 0xffff0000u); S2 = S2 * d.z + __uint_as_float(x.y << 16); S3 = S3 * d.w + __uint_as_float(x.y & 0xffff0000u); }
    }
}
__device__ __forceinline__ void phase_gla_b3(const Args& a, LAS unsigned char* lds, int tid, int lane, int wave) {
    LAS bf16_t* ST = (LAS bf16_t*)lds;
    LAS bf16_t* QD = (LAS bf16_t*)(lds + 69632);
    LAS float* PS = (LAS float*)(lds + 69632 + 17408);
    const f32x4 zero = {0.f, 0.f, 0.f, 0.f};
    const int ql = lane & 15, quad = lane >> 4, tm = wave >> 1, cb0 = (wave & 1) * 128;
    for (int u = blockIdx.x; u < GUNITS; u += gridDim.x) {
        const int b = u / (4 * GCH), h = (u / GCH) & 3, n = u % GCH; const int r0 = b * LL + 64 * n;
#pragma unroll
        for (int i = 0; i < 8; ++i) { const int idx = tid + 512 * i, j = idx >> 4, ch = idx & 15; *(LAS bf16x8*)(ST + j * 136 + ch * 8) = *(const bf16x8*)(WSP(const bf16_t, WS_SPT) + ((size_t)u * 256 + j) * 128 + ch * 8); }
#pragma unroll
        for (int i = 0; i < 2; ++i) { const int idx = tid + 512 * i, t = idx >> 4, ch = idx & 15; *(LAS bf16x8*)(QD + t * 136 + ch * 8) = *(const bf16x8*)(WSP(bf16_t, WS_QDG) + (size_t)(r0 + t) * 512 + h * 128 + ch * 8); }
        const int t = 16 * tm + ql;
        u32x2 gr[8];
        { const bf16_t* gp = WSP(const bf16_t, WS_PROJ) + (size_t)(r0 + t) * NPROJ + PC_GR + h * 256 + cb0 + quad * 4;
#pragma unroll
          for (int q = 0; q < 8; ++q) gr[q] = *(const u32x2*)(gp + 16 * q); }
        __syncthreads();
        f32x4 o[8]; float ss = 0.f;
#pragma unroll
        for (int q = 0; q < 8; ++q) { o[q] = mma16(ST + (cb0 + 16 * q) * 136, 136, QD + 16 * tm * 136, 136, 128, lane, zero);
            const u32x2 g = *(const u32x2*)(WSP(const bf16_t, WS_OG) + (size_t)(r0 + t) * 1024 + h * 256 + cb0 + 16 * q + quad * 4);
            o[q][0] += __uint_as_float(g.x << 16); o[q][1] += __uint_as_float(g.x & 0xffff0000u); o[q][2] += __uint_as_float(g.y << 16); o[q][3] += __uint_as_float(g.y & 0xffff0000u);
            ss += (o[q][0] * o[q][0] + o[q][1] * o[q][1]) + (o[q][2] * o[q][2] + o[q][3] * o[q][3]); }
        ss += __shfl_xor(ss, 16); ss += __shfl_xor(ss, 32);
        if (quad == 0) PS[wave * 16 + ql] = ss;
        __syncthreads();
        { const float tot = PS[wave * 16 + ql] + PS[(wave ^ 1) * 16 + ql];
            const float rs = 1.0f / sqrtf(tot * (1.0f / 256.f) + EPS);
            bf16_t* op = WSP(bf16_t, WS_MIX) + (size_t)(r0 + t) * DM + 1536 + h * 256 + cb0 + quad * 4;
#pragma unroll
            for (int q = 0; q < 8; ++q) { float y[4];
#pragma unroll
                for (int e4 = 0; e4 < 4; ++e4) { const unsigned gw_ = e4 < 2 ? gr[q].x : gr[q].y; const float g = __uint_as_float((e4 & 1) ? (gw_ & 0xffff0000u) : (gw_ << 16));
                    y[e4] = o[q][e4] * rs * (g * __builtin_amdgcn_rcpf(1.0f + __expf(-g))); }
                u32x2 w; w.x = pk2(y[0], y[1]); w.y = pk2(y[2], y[3]); *(u32x2*)(op + 16 * q) = w; } }
        __syncthreads();
    }
}


namespace att {
typedef short s16x4 __attribute__((ext_vector_type(4)));
typedef float f32x16 __attribute__((ext_vector_type(16)));
constexpr int SHM_K = 16384, SHM_V = 16384, SHM_KP = 8192;
constexpr int OFF_V = 0, OFF_K = 2 * SHM_V, OFF_KP = OFF_K + 2 * SHM_K, OFF_BIAS = OFF_KP + 2 * SHM_KP, OFF_WS = OFF_BIAS + 512, OFF_VOTE = OFF_WS + 8 * 64 * 4, ATT_LDS = OFF_VOTE + 64;
static_assert(ATT_LDS <= RING_BYTES, "attention LDS");
constexpr float LOG2E = 1.4426950408889634f, THR2 = 8.f * 1.4426950408889634f;
#define ATT_KSWZ(row, colB) ((row) * 256 + ((colB) ^ (((row) & 15) << 4)))
#define ATT_KPSWZ(row, colB) ((row) * 128 + ((colB) ^ ((((row) >> 1) & 7) << 4)))
#define ATT_SBAR() __builtin_amdgcn_sched_barrier(0)
__device__ __forceinline__ int v_st(int k, int c) { const int kk = (k & ~0xC) | ((k & 4) << 1) | ((k & 8) >> 1); return ((kk >> 3) * 4 + (c >> 5)) * 512 + ((kk & 7) * 32 + (c & 31)) * 2; }
__device__ __forceinline__ int v_rd_base(int lane) { return ((lane & 3) << 3) | (((lane >> 2) & 3) << 6) | (((lane >> 4) & 1) << 5) | (((lane >> 5) & 1) << 8); }
constexpr int v_rd_off(int d0, int ks, int half) { return d0 * 512 + ks * 4096 + half * 2048; }
__device__ __forceinline__ int crow(int r, int hi) { return (r & 3) + 8 * (r >> 2) + 4 * hi; }
__device__ __forceinline__ unsigned cvtpk(float lo, float hi) { unsigned r; asm volatile("v_cvt_pk_bf16_f32 %0, %1, %2" : "=v"(r) : "v"(lo), "v"(hi)); return r; }

template <int KB, int TYPE>
__device__ __forceinline__ void qkt(f32x16& p0, f32x16& p1, const LAS char* lds, int r32, int hi, const bf16x8* qr, const bf16x8* qpe) {
    p0 = f32x16{}; p1 = f32x16{};
    int ko[4];
#pragma unroll
    for (int dd = 0; dd < 4; ++dd) ko[dd] = ATT_KSWZ(r32, (dd * 16 + hi * 8) * 2);
    int kx = 128; asm volatile("" : "+v"(kx));
    constexpr int NS = TYPE == 0 ? 12 : 8;
    bf16x8 c0, c1, n0, n1;
#define ATT_KRD(s_, x0, x1) do { if ((s_) < 8) { const LAS char* ka = lds + OFF_K + KB * SHM_K + ((s_) < 4 ? ko[(s_) & 3] : (ko[(s_) & 3] ^ kx)); \
            x0 = *reinterpret_cast<const LAS bf16x8*>(ka); x1 = *reinterpret_cast<const LAS bf16x8*>(ka + 32 * 256); } \
        else { const LAS char* ka = lds + OFF_KP + KB * SHM_KP + ATT_KPSWZ(r32, ((((s_) - 8) & 3) * 16 + hi * 8) * 2); \
            x0 = *reinterpret_cast<const LAS bf16x8*>(ka); x1 = *reinterpret_cast<const LAS bf16x8*>(ka + 32 * 128); } } while (0)
    ATT_KRD(0, c0, c1);
#pragma unroll
    for (int s = 0; s < NS; ++s) {
        if (s + 1 < NS) ATT_KRD(s + 1, n0, n1);
        ATT_SBAR();
        const bf16x8 qq = s < 8 ? qr[s & 7] : qpe[(s - 8) & 3];
        p0 = __builtin_amdgcn_mfma_f32_32x32x16_bf16(c0, qq, p0, 0, 0, 0);
        p1 = __builtin_amdgcn_mfma_f32_32x32x16_bf16(c1, qq, p1, 0, 0, 0);
        ATT_SBAR();
        c0 = n0; c1 = n1;
    }
#undef ATT_KRD
}
template <int VB>
__device__ __forceinline__ void pv_tile(f32x16* o, int vb0, bf16x8 pa0, bf16x8 pa1, bf16x8 pa2, bf16x8 pa3) {
#define ATT_TRRD(dst, off) asm volatile("ds_read_b64_tr_b16 %0, %1 offset:%2" : "=&v"(dst) : "v"(vb0), "i"(off) : "memory")
    s16x4 L0[4], H0[4], L1[4], H1[4];
#define ATT_PV_RD(d0, L, H) do { constexpr int b_ = OFF_V + VB * SHM_V + v_rd_off(d0, 0, 0); \
        ATT_TRRD(L[0], b_); ATT_TRRD(H[0], b_ + 2048); ATT_TRRD(L[1], b_ + 4096); ATT_TRRD(H[1], b_ + 6144); ATT_TRRD(L[2], b_ + 8192); ATT_TRRD(H[2], b_ + 10240); ATT_TRRD(L[3], b_ + 12288); ATT_TRRD(H[3], b_ + 14336); } while (0)
#define ATT_PV_MM(d0, L, H) do { \
        o[d0] = __builtin_amdgcn_mfma_f32_32x32x16_bf16(pa0, (bf16x8){L[0][0], L[0][1], L[0][2], L[0][3], H[0][0], H[0][1], H[0][2], H[0][3]}, o[d0], 0, 0, 0);   \
        o[d0] = __builtin_amdgcn_mfma_f32_32x32x16_bf16(pa1, (bf16x8){L[1][0], L[1][1], L[1][2], L[1][3], H[1][0], H[1][1], H[1][2], H[1][3]}, o[d0], 0, 0, 0);   \
        o[d0] = __builtin_amdgcn_mfma_f32_32x32x16_bf16(pa2, (bf16x8){L[2][0], L[2][1], L[2][2], L[2][3], H[2][0], H[2][1], H[2][2], H[2][3]}, o[d0], 0, 0, 0);   \
        o[d0] = __builtin_amdgcn_mfma_f32_32x32x16_bf16(pa3, (bf16x8){L[3][0], L[3][1], L[3][2], L[3][3], H[3][0], H[3][1], H[3][2], H[3][3]}, o[d0], 0, 0, 0); } while (0)
    ATT_PV_RD(0, L0, H0);
    ATT_PV_RD(1, L1, H1); asm volatile("s_waitcnt lgkmcnt(8)" ::: "memory"); ATT_SBAR(); ATT_PV_MM(0, L0, H0); ATT_SBAR();
    ATT_PV_RD(2, L0, H0); asm volatile("s_waitcnt lgkmcnt(8)" ::: "memory"); ATT_SBAR(); ATT_PV_MM(1, L1, H1); ATT_SBAR();
    ATT_PV_RD(3, L1, H1); asm volatile("s_waitcnt lgkmcnt(8)" ::: "memory"); ATT_SBAR(); ATT_PV_MM(2, L0, H0); ATT_SBAR();
    asm volatile("s_waitcnt lgkmcnt(0)" ::: "memory"); ATT_SBAR(); ATT_PV_MM(3, L1, H1);
#undef ATT_PV_MM
#undef ATT_PV_RD
#undef ATT_TRRD
}
template <int TYPE>
__device__ __forceinline__ void softmax_tile(f32x16& p0, f32x16& p1, float& m_reg, float& l_reg, float& alpha, bf16x8& pa0, bf16x8& pa1, bf16x8& pa2, bf16x8& pa3,
                                             const LAS float* bias, int hi, bool need_mask, int lo, int dq) {
    constexpr float C2 = (TYPE == 0 ? 0.07216878364870322f : 0.08838834764831845f) * LOG2E;
    if (TYPE == 1) {
#pragma unroll
        for (int g = 0; g < 4; ++g) { const f32x4 b0 = *(const LAS f32x4*)(bias + 8 * g + 4 * hi), b1 = *(const LAS f32x4*)(bias + 32 + 8 * g + 4 * hi);
#pragma unroll
            for (int i = 0; i < 4; ++i) { p0[4 * g + i] = fmaf(p0[4 * g + i], C2, b0[i]); p1[4 * g + i] = fmaf(p1[4 * g + i], C2, b1[i]); } }
    }
    if (need_mask) {
        const float NEG = -__builtin_inff(); const int loh = lo - 4 * hi, dqh = dq - 4 * hi;
#pragma unroll
        for (int r = 0; r < 16; ++r) { const int c = (r & 3) + 8 * (r >> 2);
            if (c < loh || c > dqh) p0[r] = NEG;
            if (c + 32 < loh || c + 32 > dqh) p1[r] = NEG; }
    }
    float pmax = p0[0];
#pragma unroll
    for (int r = 1; r < 16; ++r) pmax = fmaxf(pmax, p0[r]);
#pragma unroll
    for (int r = 0; r < 16; ++r) pmax = fmaxf(pmax, p1[r]);
    { auto rr = __builtin_amdgcn_permlane32_swap(__float_as_uint(pmax), __float_as_uint(pmax), false, false);
      pmax = fmaxf(__uint_as_float(rr[0]), __uint_as_float(rr[1])); }
    float mn;
    if (__builtin_expect(__all(pmax - m_reg <= THR2), 1)) { mn = m_reg; alpha = 1.f; }
    else { mn = fmaxf(m_reg, pmax); alpha = __builtin_amdgcn_exp2f(m_reg - mn); m_reg = mn; }
#pragma unroll
    for (int r = 0; r < 16; ++r) { p0[r] = __builtin_amdgcn_exp2f(p0[r] - mn); p1[r] = __builtin_amdgcn_exp2f(p1[r] - mn); }
    float ps = 0.f;
#pragma unroll
    for (int r = 0; r < 16; ++r) ps += p0[r];
#pragma unroll
    for (int r = 0; r < 16; ++r) ps += p1[r];
    { auto rr = __builtin_amdgcn_permlane32_swap(__float_as_uint(ps), __float_as_uint(ps), false, false);
      ps = __uint_as_float(rr[0]) + __uint_as_float(rr[1]); }
    l_reg = l_reg * alpha + ps;
#define ATT_PK4(P, B_, OUT) do { unsigned a0 = cvtpk(P[B_+0], P[B_+1]), a1 = cvtpk(P[B_+2], P[B_+3]);                          \
        unsigned b0 = cvtpk(P[B_+4], P[B_+5]), b1 = cvtpk(P[B_+6], P[B_+7]);                                             \
        auto r0 = __builtin_amdgcn_permlane32_swap(a0, b0, false, false); auto r1 = __builtin_amdgcn_permlane32_swap(a1, b1, false, false); \
        u32x4 w = {r0[0], r1[0], r0[1], r1[1]}; OUT = *reinterpret_cast<bf16x8*>(&w); } while (0)
    ATT_PK4(p0, 0, pa0); ATT_PK4(p0, 8, pa1); ATT_PK4(p1, 0, pa2); ATT_PK4(p1, 8, pa3);
#undef ATT_PK4
}

template <int TYPE>
__device__ __forceinline__ void attn_block(const Args& a, LAS char* lds, int b, int h, int q0, int row_store_end, int tid, int lane, int wid) {
    const int r32 = lane & 31, hi = lane >> 5;
    const size_t rb = (size_t)b * LL;
    constexpr int QS = TYPE == 0 ? NQ : NPROJ, KS = TYPE == 0 ? NKV : NPROJ;
    const bf16_t* Qn = TYPE == 0 ? WSP(const bf16_t, WS_QM) + h * 128 : WSP(const bf16_t, WS_PROJ) + PC_FQ + h * 128;
    const bf16_t* Kn = TYPE == 0 ? WSP(const bf16_t, WS_KVM) + h * 128 : WSP(const bf16_t, WS_PROJ) + PC_FK + h * 128;
    const bf16_t* Vv = TYPE == 0 ? WSP(const bf16_t, WS_KVM) + 1536 + h * 128 : WSP(const bf16_t, WS_PROJ) + PC_FV + h * 128;
    const bf16_t* Kp = WSP(const bf16_t, WS_KPE);
    const float* cf = WSP(const float, WS_CF) + ((size_t)b * 12 + h) * LL;
    const int qrow = q0 + wid * 32 + r32, qlo = q0 + wid * 32;
    bf16x8 qr[8], qpe[4];
#pragma unroll
    for (int d0 = 0; d0 < 8; ++d0) qr[d0] = *(const bf16x8*)(Qn + (rb + qrow) * QS + d0 * 16 + hi * 8);
#pragma unroll
    for (int d0 = 0; d0 < 4; ++d0) qpe[d0] = TYPE == 0 ? *(const bf16x8*)(WSP(const bf16_t, WS_QM) + (rb + qrow) * NQ + 1536 + h * 64 + d0 * 16 + hi * 8) : qr[0];
    const int NT = (q0 + 256) / 64 - 1;
    const int sr = tid >> 4, sc = (tid & 15) * 8, kws = ATT_KSWZ(sr, sc * 2), vst0 = v_st(sr, sc), vst1 = v_st(32 + sr, sc);
    const int kpkey = tid >> 3, kpch = tid & 7, kpws = ATT_KPSWZ(kpkey, kpch * 16);
    const int vb0 = (int)(unsigned)(uintptr_t)(lds + OFF_V) + v_rd_base(lane);
    LAS float* wsl = (LAS float*)(lds + OFF_WS) + wid * 64; LAS float* li_l = wsl; LAS float* al_l = wsl + 32;
    LAS unsigned* votes = (LAS unsigned*)(lds + OFF_VOTE);
    bf16x8 sk0, sk1, sv0, sv1, skp; float sbias = 0.f;
    const unsigned koff = (unsigned)(sr * KS + sc) * 2u, kpoff = (unsigned)(kpkey * 64 + kpch * 8) * 2u, boff = (unsigned)(tid & 63) * 4u;
    float qn = 0.f;
    if (TYPE == 1) {
#pragma unroll
        for (int d0 = 0; d0 < 8; ++d0)
#pragma unroll
            for (int e = 0; e < 8; ++e) { const float x = bf2f((bf16_t)qr[d0][e]); qn += x * x; }
        { auto rr = __builtin_amdgcn_permlane32_swap(__float_as_uint(qn), __float_as_uint(qn), false, false); qn = __uint_as_float(rr[0]) + __uint_as_float(rr[1]); }
        qn = sqrtf(qn) * (0.08838834764831845f * LOG2E * 1.001f);
    }
    const float* kpm = WSP(const float, WS_KPM) + ((size_t)b * 12 + h) * (LL / 64);
#define ATT_LOADT(kb) do { const char* kt_ = (const char*)(Kn + (rb + (kb)) * KS); const char* vt_ = (const char*)(Vv + (rb + (kb)) * KS); \
        sk0 = *(const bf16x8*)(kt_ + koff); sk1 = *(const bf16x8*)(kt_ + (size_t)32 * KS * 2 + koff); \
        sv0 = *(const bf16x8*)(vt_ + koff); sv1 = *(const bf16x8*)(vt_ + (size_t)32 * KS * 2 + koff); \
        if (TYPE == 0) skp = *(const bf16x8*)((const char*)(Kp + (rb + (kb)) * 64) + kpoff); \
        if (TYPE == 1 && tid < 64) sbias = *(const float*)((const char*)(cf + (kb)) + boff); } while (0)
#define ATT_WRITET(bf) do { *(LAS bf16x8*)(lds + OFF_K + (bf) * SHM_K + kws) = sk0; *(LAS bf16x8*)(lds + OFF_K + (bf) * SHM_K + kws + 32 * 256) = sk1; \
        *(LAS bf16x8*)(lds + OFF_V + (bf) * SHM_V + vst0) = sv0; *(LAS bf16x8*)(lds + OFF_V + (bf) * SHM_V + vst1) = sv1; \
        if (TYPE == 0) *(LAS bf16x8*)(lds + OFF_KP + (bf) * SHM_KP + kpws) = skp; \
        if (TYPE == 1 && tid < 64) *(LAS float*)(lds + OFF_BIAS + (bf) * 256 + tid * 4) = -sbias * LOG2E; } while (0)
    float m_reg = -1e30f, l_reg = 0.f, alpha = 1.f; f32x16 o[4] = {};
    f32x16 p0, p1; bf16x8 pa0, pa1, pa2, pa3;
    bool stop = false;
    __syncthreads();
    ATT_LOADT(64 * NT); ATT_WRITET(0);
    __syncthreads();
#define ATT_STEP(t, BUF) do { const int kb_ = 64 * (NT - (t)); const bool more_ = (t) + 1 < NT; \
        if (more_) ATT_LOADT(kb_ - 64); \
        ATT_SBAR(); __builtin_amdgcn_s_setprio(1); qkt<BUF, TYPE>(p0, p1, lds, r32, hi, qr, qpe); __builtin_amdgcn_s_setprio(0); \
        softmax_tile<TYPE>(p0, p1, m_reg, l_reg, alpha, pa0, pa1, pa2, pa3, (const LAS float*)(lds + OFF_BIAS + (BUF) * 256), hi, kb_ == 64 || kb_ + 63 > qlo, NPAD - kb_, qrow - kb_); \
        if (TYPE == 1 && more_) { const float bnd_ = qn * kpm[kb_ / 64 - 1] - cf[kb_ - 1] * LOG2E; const bool ok_ = (bnd_ - m_reg < -170.f) || (qrow < NPAD); \
            const bool all_ = __all(ok_); if (lane == 0) votes[((t) & 1) * 8 + wid] = all_ ? 1u : 0u; } \
        if (__any(alpha < 1.f)) { if (hi == 0) al_l[r32] = alpha; asm volatile("s_waitcnt lgkmcnt(0)" ::: "memory"); \
            _Pragma("unroll") for (int d_ = 0; d_ < 4; ++d_) _Pragma("unroll") for (int r = 0; r < 16; ++r) o[d_][r] *= al_l[crow(r, hi)]; } \
        ATT_SBAR(); __builtin_amdgcn_s_setprio(1); pv_tile<BUF>(o, vb0, pa0, pa1, pa2, pa3); __builtin_amdgcn_s_setprio(0); \
        if (more_) ATT_WRITET((BUF) ^ 1); \
        __syncthreads(); \
        if (TYPE == 1 && more_) { const u32x4 va_ = *(const LAS u32x4*)(votes + ((t) & 1) * 8), vb_ = *(const LAS u32x4*)(votes + ((t) & 1) * 8 + 4); \
            stop = (va_[0] & va_[1] & va_[2] & va_[3] & vb_[0] & vb_[1] & vb_[2] & vb_[3]) != 0u; } } while (0)
#define ATT_SKIP(t, BUF) do { const int kb_ = 64 * (NT - (t)); const bool more_ = (t) + 1 < NT; \
        if (more_) ATT_LOADT(kb_ - 64); \
        if (TYPE == 1 && more_ && lane == 0) votes[((t) & 1) * 8 + wid] = 0u;        \
        if (more_) ATT_WRITET((BUF) ^ 1); \
        __syncthreads(); } while (0)
    int t = 0;
    { int ts = NT - (qlo + 31) / 64; ts = (ts < 0 ? 0 : ts > NT ? NT : ts) & ~1;
      for (; t < ts; t += 2) { ATT_SKIP(t, 0); ATT_SKIP(t + 1, 1); } }
#undef ATT_SKIP
    for (; t + 1 < NT && !stop; t += 2) { ATT_STEP(t, 0); if (!stop) ATT_STEP(t + 1, 1); }
    if (!stop && t < NT) ATT_STEP(t, 0);
    if (hi == 0) li_l[r32] = l_reg;
    asm volatile("s_waitcnt lgkmcnt(0)" ::: "memory");
    if (qlo < row_store_end) {
        int hoff = 4 * hi; asm volatile("" : "+v"(hoff));
        bf16_t* Ow = WSP(bf16_t, WS_MIX) + (rb + qlo) * DM + (TYPE == 0 ? 0 : 2560) + h * 128 + r32;
#pragma unroll
        for (int r = 0; r < 16; ++r) { const int orow = (r & 3) + 8 * (r >> 2) + hoff; const float lv = li_l[orow]; const float inv = lv > 0.f ? __builtin_amdgcn_rcpf(lv) : 0.f;
            const float x0 = o[0][r] * inv, x1 = o[1][r] * inv, x2 = o[2][r] * inv, x3 = o[3][r] * inv;
            float ss = (x0 * x0 + x1 * x1) + (x2 * x2 + x3 * x3);
            ss += __shfl_xor(ss, 1); ss += __shfl_xor(ss, 2); ss += __shfl_xor(ss, 4); ss += __shfl_xor(ss, 8); ss += __shfl_xor(ss, 16);
            const float rs = 1.0f / sqrtf(ss * (1.0f / 128.f) + EPS);
            bf16_t* op = Ow + (size_t)orow * DM;
            op[0] = f2bf(x0 * rs); op[32] = f2bf(x1 * rs); op[64] = f2bf(x2 * rs); op[96] = f2bf(x3 * rs); }
    }
#undef ATT_LOADT
#undef ATT_WRITET
#undef ATT_STEP
}
}
constexpr int ATT_SCHED_LEN = 4;
__device__ const unsigned short ATT_SCHED[256][4] = {
{15,696,65535,65535},
{32,713,65535,65535},
{49,730,65535,65535},
{66,747,65535,65535},
{83,764,65535,65535},
{100,781,65535,65535},
{117,798,65535,65535},
{134,815,65535,65535},
{151,65535,65535,65535},
{168,65535,65535,65535},
{185,65535,65535,65535},
{202,65535,65535,65535},
{219,65535,65535,65535},
{236,65535,65535,65535},
{253,65535,65535,65535},
{270,65535,65535,65535},
{287,65535,65535,65535},
{304,65535,65535,65535},
{321,65535,65535,65535},
{338,65535,65535,65535},
{355,65535,65535,65535},
{372,65535,65535,65535},
{389,65535,65535,65535},
{406,65535,65535,65535},
{14,272,65535,65535},
{31,289,65535,65535},
{48,306,65535,65535},
{65,323,65535,65535},
{82,340,65535,65535},
{99,357,65535,65535},
{116,374,65535,65535},
{133,391,65535,65535},
{150,408,65535,65535},
{167,425,65535,65535},
{184,442,65535,65535},
{201,459,65535,65535},
{218,476,65535,65535},
{235,493,65535,65535},
{252,510,65535,65535},
{269,527,65535,65535},
{286,544,65535,65535},
{303,561,65535,65535},
{320,578,65535,65535},
{337,595,65535,65535},
{354,612,65535,65535},
{371,629,65535,65535},
{388,646,65535,65535},
{405,663,65535,65535},
{13,682,65535,65535},
{30,699,65535,65535},
{47,716,65535,65535},
{64,733,65535,65535},
{81,750,65535,65535},
{98,767,65535,65535},
{115,784,65535,65535},
{132,801,65535,65535},
{149,683,65535,65535},
{166,700,65535,65535},
{183,717,65535,65535},
{200,734,65535,65535},
{217,751,65535,65535},
{234,768,65535,65535},
{251,785,65535,65535},
{268,802,65535,65535},
{285,684,65535,65535},
{302,701,65535,65535},
{319,718,65535,65535},
{336,735,65535,65535},
{353,752,65535,65535},
{370,769,65535,65535},
{387,786,65535,65535},
{404,803,65535,65535},
{12,551,680,65535},
{29,568,697,65535},
{46,585,714,65535},
{63,602,731,65535},
{80,619,748,65535},
{97,636,765,65535},
{114,653,782,65535},
{131,670,799,65535},
{148,552,16,65535},
{165,569,33,65535},
{182,586,50,65535},
{199,603,67,65535},
{216,620,84,65535},
{233,637,101,65535},
{250,654,118,65535},
{267,671,135,65535},
{284,553,152,65535},
{301,570,169,65535},
{318,587,186,65535},
{335,604,203,65535},
{352,621,220,65535},
{369,638,237,65535},
{386,655,254,65535},
{403,672,271,65535},
{11,417,685,65535},
{28,434,702,65535},
{45,451,719,65535},
{62,468,736,65535},
{79,485,753,65535},
{96,502,770,65535},
{113,519,787,65535},
{130,536,804,65535},
{147,418,686,65535},
{164,435,703,65535},
{181,452,720,65535},
{198,469,737,65535},
{215,486,754,65535},
{232,503,771,65535},
{249,520,788,65535},
{266,537,805,65535},
{283,419,687,65535},
{300,436,704,65535},
{317,453,721,65535},
{334,470,738,65535},
{351,487,755,65535},
{368,504,772,65535},
{385,521,789,65535},
{402,538,806,65535},
{10,410,554,288},
{27,427,571,305},
{44,444,588,322},
{61,461,605,339},
{78,478,622,356},
{95,495,639,373},
{112,512,656,390},
{129,529,673,407},
{146,411,555,424},
{163,428,572,441},
{180,445,589,458},
{197,462,606,475},
{214,479,623,492},
{231,496,640,509},
{248,513,657,526},
{265,530,674,543},
{282,412,556,560},
{299,429,573,577},
{316,446,590,594},
{333,463,607,611},
{350,480,624,628},
{367,497,641,645},
{384,514,658,662},
{401,531,675,679},
{9,137,421,689},
{26,154,438,706},
{43,171,455,723},
{60,188,472,740},
{77,205,489,757},
{94,222,506,774},
{111,239,523,791},
{128,256,540,808},
{145,273,422,690},
{162,290,439,707},
{179,307,456,724},
{196,324,473,741},
{213,341,490,758},
{230,358,507,775},
{247,375,524,792},
{264,392,541,809},
{281,409,420,688},
{298,426,437,705},
{315,443,454,722},
{332,460,471,739},
{349,477,488,756},
{366,494,505,773},
{383,511,522,790},
{400,528,539,807},
{8,138,423,691},
{25,155,440,708},
{42,172,457,725},
{59,189,474,742},
{76,206,491,759},
{93,223,508,776},
{110,240,525,793},
{127,257,542,810},
{144,274,545,692},
{161,291,562,709},
{178,308,579,726},
{195,325,596,743},
{212,342,613,760},
{229,359,630,777},
{246,376,647,794},
{263,393,664,811},
{280,1,413,557},
{297,18,430,574},
{314,35,447,591},
{331,52,464,608},
{348,69,481,625},
{365,86,498,642},
{382,103,515,659},
{399,120,532,676},
{7,139,546,693},
{24,156,563,710},
{41,173,580,727},
{58,190,597,744},
{75,207,614,761},
{92,224,631,778},
{109,241,648,795},
{126,258,665,812},
{143,275,547,694},
{160,292,564,711},
{177,309,581,728},
{194,326,598,745},
{211,343,615,762},
{228,360,632,779},
{245,377,649,796},
{262,394,666,813},
{279,2,414,558},
{296,19,431,575},
{313,36,448,592},
{330,53,465,609},
{347,70,482,626},
{364,87,499,643},
{381,104,516,660},
{398,121,533,677},
{6,140,548,695},
{23,157,565,712},
{40,174,582,729},
{57,191,599,746},
{74,208,616,763},
{91,225,633,780},
{108,242,650,797},
{125,259,667,814},
{142,276,549,0},
{159,293,566,17},
{176,310,583,34},
{193,327,600,51},
{210,344,617,68},
{227,361,634,85},
{244,378,651,102},
{261,395,668,119},
{278,3,415,559},
{295,20,432,576},
{312,37,449,593},
{329,54,466,610},
{346,71,483,627},
{363,88,500,644},
{380,105,517,661},
{397,122,534,678},
{5,277,550,136},
{22,294,567,153},
{39,311,584,170},
{56,328,601,187},
{73,345,618,204},
{90,362,635,221},
{107,379,652,238},
{124,396,669,255},
{141,4,416,681},
{158,21,433,698},
{175,38,450,715},
{192,55,467,732},
{209,72,484,749},
{226,89,501,766},
{243,106,518,783},
{260,123,535,800}
};
constexpr int ATT_UNITS2 = 2 * 2 * 12 * 17;
__device__ __forceinline__ void att_unit(const Args& a, LAS char* lds, int uid, int tid, int lane, int wid) {
    const int blk = uid % 17, rest = uid / 17, h = rest % 12, tb = rest / 12, b = tb & 1, ty = tb >> 1;
    const int q0 = blk == 16 ? 0 : 128 + 256 * blk, rse = blk == 16 ? 128 : (1 << 30);
    if (ty == 0) att::attn_block<0>(a, lds, b, h, q0, rse, tid, lane, wid); else att::attn_block<1>(a, lds, b, h, q0, rse, tid, lane, wid);
}
__device__ __forceinline__ void phase_attn2(const Args& a, LAS unsigned char* lds_, int tid, int lane, int wid) {
    LAS char* lds = (LAS char*)lds_;
    const bool tab = gridDim.x == 256;
    for (int k = 0; ; ++k) {
        int uid;
        if (tab) { if (k >= ATT_SCHED_LEN) break; uid = ATT_SCHED[blockIdx.x][k]; if (uid == 0xFFFF) break; }
        else { uid = blockIdx.x + k * gridDim.x; if (uid >= ATT_UNITS2) break; }
        att_unit(a, lds, uid, tid, lane, wid);
    }
}

__device__ __forceinline__ void phase_mixnorm(const Args& a, int gw, int NGW, int lane) {
    for (int row = gw; row < R; row += NGW) {
        const f32x4* src = (const f32x4*)(WSP(float, WS_OG) + (size_t)row * DM); u32x2* dst = (u32x2*)(WSP(bf16_t, WS_MIX) + (size_t)row * DM);
#pragma unroll
        for (int j = 0; j < 16; ++j) {
            f32x4 v = src[64 * j + lane];
            float ss = (v.x * v.x + v.y * v.y) + (v.z * v.z + v.w * v.w);
            ss += __shfl_xor(ss, 1); ss += __shfl_xor(ss, 2); ss += __shfl_xor(ss, 4); ss += __shfl_xor(ss, 8); ss += __shfl_xor(ss, 16);
            float rs;
            if (j >= 6 && j < 10) { ss += __shfl_xor(ss, 32); rs = 1.0f / sqrtf(ss * (1.0f / 256.f) + EPS);
                const u32x2 g = *(const u32x2*)(WSP(bf16_t, WS_PROJ) + (size_t)row * NPROJ + PC_GR + (j - 6) * 256 + 4 * lane);
                const float g0 = __uint_as_float(g.x << 16), g1 = __uint_as_float(g.x & 0xffff0000u), g2 = __uint_as_float(g.y << 16), g3 = __uint_as_float(g.y & 0xffff0000u);
                v.x *= rs * (g0 / (1.0f + __expf(-g0))); v.y *= rs * (g1 / (1.0f + __expf(-g1))); v.z *= rs * (g2 / (1.0f + __expf(-g2))); v.w *= rs * (g3 / (1.0f + __expf(-g3)));
            } else { rs = 1.0f / sqrtf(ss * (1.0f / 128.f) + EPS); v = v * rs; }
            u32x2 w; w.x = pk2(v.x, v.y); w.y = pk2(v.z, v.w); dst[64 * j + lane] = w;
        }
    }
}

__device__ __forceinline__ void phase_convfix(const Args& a, int layer, int tid) {
    const float* cw = a.in[17] + (size_t)layer * 3 * NUP; const float* cb = a.in[18] + (size_t)layer * NUP;
    const float* UM = WSP(const float, WS_UM); const float* EDGE = WSP(const float, WS_EDGE);
    constexpr int NCH = DFF / 8, NROWS = 16 + 64;
    for (int item = blockIdx.x * 512 + tid; item < NROWS * NCH; item += gridDim.x * 512) {
        const int rr = item / NCH, chk = item - rr * NCH, ch0 = chk * 8, gcol = (ch0 >> 7) * 256 + (ch0 & 127);
        const float* X; const float* P1; const float* P2; int orow0, orow1;
        if (rr < 16) { X = UM + (size_t)rr * NUP; P1 = rr >= 1 ? UM + (size_t)(rr - 1) * NUP : nullptr; P2 = rr >= 2 ? UM + (size_t)(rr - 2) * NUP : nullptr; orow0 = NPAD + rr; orow1 = LL + NPAD + rr; }
        else { const int k = rr - 16, pm = k >> 1, j = k & 1; const bool i0 = (pm & 15) == 0; const float* E = EDGE + (size_t)pm * 4 * NUP;
            const float* prev3 = i0 ? UM + (size_t)15 * NUP : E - (size_t)1 * NUP; const float* prev2 = i0 ? UM + (size_t)14 * NUP : E - (size_t)2 * NUP;
            if (j == 0) { X = E; P1 = prev3; P2 = prev2; } else { X = E + NUP; P1 = E; P2 = prev3; }
            orow0 = pg8::prow(pm) + j; orow1 = -1; }
        float o[8];
#pragma unroll
        for (int h = 0; h < 2; ++h) {
            const int cg_ = gcol + 4 * h, ch = ch0 + 4 * h;
            const f32x4 xg = *(const f32x4*)(X + cg_), xv = *(const f32x4*)(X + cg_ + 128);
            const f32x4 z = {0.f, 0.f, 0.f, 0.f};
            const f32x4 p1g = P1 ? *(const f32x4*)(P1 + cg_) : z, p1v = P1 ? *(const f32x4*)(P1 + cg_ + 128) : z, p2g = P2 ? *(const f32x4*)(P2 + cg_) : z, p2v = P2 ? *(const f32x4*)(P2 + cg_ + 128) : z;
            const f32x4 wg0 = *(const f32x4*)(cw + ch), wg1 = *(const f32x4*)(cw + NUP + ch), wg2 = *(const f32x4*)(cw + 2 * NUP + ch), bg = *(const f32x4*)(cb + ch);
            const f32x4 wv0 = *(const f32x4*)(cw + DFF + ch), wv1 = *(const f32x4*)(cw + NUP + DFF + ch), wv2 = *(const f32x4*)(cw + 2 * NUP + DFF + ch), bv = *(const f32x4*)(cb + DFF + ch);
#pragma unroll
            for (int e = 0; e < 4; ++e) { const float cg = bg[e] + wg0[e] * p2g[e] + wg1[e] * p1g[e] + wg2[e] * xg[e], cv = bv[e] + wv0[e] * p2v[e] + wv1[e] * p1v[e] + wv2[e] * xv[e];
                o[4 * h + e] = cg * __builtin_amdgcn_rcpf(1.0f + __expf(-cg)) * cv; }
        }
        u32x4 w; w.x = pk2(o[0], o[1]); w.y = pk2(o[2], o[3]); w.z = pk2(o[4], o[5]); w.w = pk2(o[6], o[7]);
        *(u32x4*)(WSP(bf16_t, WS_ACT) + (size_t)orow0 * DFF + ch0) = w;
        if (orow1 >= 0) *(u32x4*)(WSP(bf16_t, WS_ACT) + (size_t)orow1 * DFF + ch0) = w;
    }
}

constexpr int NPH_LAYER = 12, NPHASES = 1 + 2 * NPH_LAYER;
#define IN(k) (lo <= (k) && (k) < hi)
#define SEAM(k) do { if (IN(k) && IN((k) + 1)) xcd_barrier(bar); } while (0)
#define SEAM2(k, kn) do { if (IN(k) && IN(kn)) xcd_barrier(bar); } while (0)
#define TIDX() int lane_x; asm volatile("v_mbcnt_lo_u32_b32 %0, -1, 0\n\tv_mbcnt_hi_u32_b32 %0, -1, %0" : "=v"(lane_x)); const int lane = lane_x, wave = wave_s, tid = wave * 64 + lane; const int gw = blockIdx.x * 8 + wave, NGW = gridDim.x * 8; (void)gw; (void)NGW; (void)lane
template <int LAYER>
__device__ __forceinline__ void layer_phases(const Args& a, const XcdBarrier& bar, LAS unsigned char* lds, int lo, int hi, const int wave_s) {
    constexpr int pb = 1 + NPH_LAYER * LAYER;
    constexpr size_t WB = WS_W + (size_t)LAYER * SZ_WLAYER;
    if (IN(pb + 0)) {
        pg8::Gemm g{WSP(bf16_t, WS_H), WSP(const bf16_t, WB + OFF_WIN), R, NIN, DM};   pg8::StaticOrder S; S.init(NB * SEQ, NIN, (int)gridDim.x, (int)blockIdx.x);
        pg8::EpiBf E{WSP(bf16_t, WS_PROJ), NPROJ, 38, 1 << 30, WSP(float, WS_SMALL), NSM, WSP(float, WS_CS), (const unsigned long long*)(a.ws + (LAYER == 0 ? WS_SS0 : WS_SS1))};
        pg8::gemm_phase<pg8::EpiBf, pg8::StaticOrder, true, true>(lds, g, S, E, wave_s);
        __syncthreads();
        { TIDX(); (void)tid; const SkEmit e{0, WSP(bf16_t, WS_PROJ), NPROJ, NPROJ, WSP(float, WS_SMALL), NSM, 1 << 30, WSP(float, WS_CS), nullptr, (const unsigned long long*)(a.ws + (LAYER == 0 ? WS_SS0 : WS_SS1)), nullptr};
          skinny_gemm(g.A, g.Bt, NIN, DM, 32 * (NIN / 256), e, lds, lane, wave); }
    }
    SEAM(pb + 0);
    if (IN(pb + 1)) { TIDX(); phase_prep_rows(a, LAYER, gw, NGW, lane); }
    SEAM(pb + 1);
    if (IN(pb + 2)) {
        { pg8::Gemm g{WSP(bf16_t, WS_CQN), WSP(const bf16_t, WB + OFF_WUQ), R, NQ, 1536}; pg8::StaticOrder S; S.init(NB * SEQ, NQ, (int)gridDim.x, (int)blockIdx.x);
          pg8::EpiBf E{WSP(bf16_t, WS_QM), NQ, 1 << 30, 6, nullptr, 0, WSP(float, WS_CS), nullptr};
          pg8::gemm_phase<pg8::EpiBf, pg8::StaticOrder, true, true>(lds, g, S, E, wave_s);
          __syncthreads();
          TIDX(); (void)tid; const SkEmit e{0, WSP(bf16_t, WS_QM), NQ, 1 << 30, nullptr, 0, 1536, WSP(float, WS_CS), nullptr, nullptr, nullptr};
          skinny_gemm(g.A, g.Bt, NQ, 1536, 32 * (NQ / 256), e, lds, lane, wave); }
        __syncthreads();
        { pg8::Gemm g{WSP(bf16_t, WS_CKVN), WSP(const bf16_t, WB + OFF_WUKV), R, NKV, 512}; pg8::StaticOrder S; S.init(NB * SEQ, NKV, (int)gridDim.x, (int)((blockIdx.x + gridDim.x / 2) % gridDim.x));
          pg8::EpiBf E{WSP(bf16_t, WS_KVM), NKV, 1 << 30, 1 << 30, nullptr, 0, WSP(float, WS_CS), nullptr};
          pg8::gemm_phase<pg8::EpiBf, pg8::StaticOrder, true, true>(lds, g, S, E, wave_s);
          __syncthreads();
          TIDX(); (void)tid; const SkEmit e{0, WSP(bf16_t, WS_KVM), NKV, 1 << 30, nullptr, 0, 1 << 30, WSP(float, WS_CS), nullptr, nullptr, nullptr};
          skinny_gemm(g.A, g.Bt, NKV, 512, 32 * (NKV / 256), e, lds, lane, wave); }
        __syncthreads();
        { TIDX(); phase_fcum(a, gw, lane); phase_gla_b1(a, lds, tid, lane, wave); }
    }
    SEAM(pb + 2);
    if (IN(pb + 3)) { TIDX(); phase_gla_b2(a, tid); }
    SEAM(pb + 3);
    if (IN(pb + 4)) { TIDX(); phase_attn2(a, lds, tid, lane, wave); __syncthreads(); phase_gla_b3(a, lds, tid, lane, wave); }
    SEAM2(pb + 4, pb + 6);
    if (IN(pb + 6)) {
        pg8::Gemm g{WSP(bf16_t, WS_MIX), WSP(const bf16_t, WB + OFF_WOUT), R, DM, DM}; pg8::StaticOrder S; S.init(NB * SEQ, DM, (int)gridDim.x, (int)blockIdx.x);
        pg8::EpiRes<false> E{WSP(bf16_t, WS_H), DM, nullptr};
        pg8::gemm_phase<pg8::EpiRes<false>, pg8::StaticOrder, true, true>(lds, g, S, E, wave_s);
        __syncthreads();
        { TIDX(); (void)tid; unsigned long long* const SSQ_ = nullptr; const SkEmit e{2, nullptr, 0, 0, nullptr, 0, 1 << 30, nullptr, WSP(bf16_t, WS_H), nullptr, SSQ_};
          skinny_gemm(g.A, g.Bt, DM, DM, 32 * (DM / 256), e, lds, lane, wave); }
    }
    SEAM(pb + 6);
    if (IN(pb + 7)) { TIDX(); norm_rows<3>(a, nullptr, gw, NGW, lane); }
    SEAM(pb + 7);
    if (IN(pb + 8)) {
        pg8::Gemm g{WSP(bf16_t, WS_HN), WSP(const bf16_t, WB + OFF_WUP), R, NUP, DM}; pg8::StaticOrder S; S.init(NB * SEQ, NUP, (int)gridDim.x, (int)blockIdx.x);
        pg8::Gemm gq{(const bf16_t*)(a.ws + WS_HNQ), (const bf16_t*)(a.ws + WS_WQ + (size_t)LAYER * SZ_WQ), R, NUP, DM / 2};
        pg8::EpiConv<true> E{WSP(bf16_t, WS_ACT), WSP(float, WS_EDGE), a.in[17] + (size_t)LAYER * 3 * NUP, a.in[18] + (size_t)LAYER * NUP, (LAS float*)(lds + MISC_OFF + 1024), WSP(const float, WS_ASC), WSP(const float, WS_WSC) + (size_t)LAYER * NUP};
        pg8::gemm_phase<pg8::EpiConv<true>, pg8::StaticOrder, true, true, true>(lds, gq, S, E, wave_s);
        __syncthreads();
        { TIDX(); (void)tid; const SkEmit e{3, nullptr, 0, 0, WSP(float, WS_UM), NUP, 1 << 30, nullptr, nullptr, nullptr, nullptr};
          skinny_gemm_i8(a.ws + WS_HNQ, a.ws + WS_WQ + (size_t)LAYER * SZ_WQ, NUP, 32 * (NUP / 256), WSP(const float, WS_ASC), WSP(const float, WS_WSC) + (size_t)LAYER * NUP, e, lds, lane, wave); (void)g; }
    }
    SEAM(pb + 8);
    if (IN(pb + 9)) { TIDX(); phase_convfix(a, LAYER, tid); }
    SEAM(pb + 9);
    if (IN(pb + 10)) {
        pg8::Gemm g{WSP(bf16_t, WS_ACT), WSP(const bf16_t, WB + OFF_WDN), R, DM, DFF}; pg8::StaticOrder S; S.init(NB * SEQ, DM, (int)gridDim.x, (int)blockIdx.x);
        unsigned long long* const SSQ_ = LAYER == 0 ? (unsigned long long*)(a.ws + WS_SS1) : nullptr;
        pg8::EpiRes<LAYER == 0> E{WSP(bf16_t, WS_H), DM, SSQ_};
        pg8::gemm_phase<pg8::EpiRes<LAYER == 0>, pg8::StaticOrder, true, true>(lds, g, S, E, wave_s);
        __syncthreads();
        { TIDX(); (void)tid; const SkEmit e{2, nullptr, 0, 0, nullptr, 0, 1 << 30, nullptr, WSP(bf16_t, WS_H), nullptr, SSQ_};
          skinny_gemm(g.A, g.Bt, DM, DFF, 32 * (DM / 256), e, lds, lane, wave); }
    }
    if (LAYER == 0) { SEAM2(pb + 10, pb + 12); }
    else { SEAM(pb + 10); if (IN(pb + 11)) { TIDX(); norm_rows<2>(a, a.in[20], gw, NGW, lane); } }
}
__global__ void __launch_bounds__(512, 2) fwd(Args a) {
    extern __shared__ __attribute__((aligned(16))) unsigned char lds_raw[];
    LAS unsigned char* lds = (LAS unsigned char*)lds_raw;
    const int lo = a.ph_lo, hi = a.ph_hi; const int wave_s = __builtin_amdgcn_readfirstlane(threadIdx.x >> 6);
    volatile LAS unsigned* MISC = (volatile LAS unsigned*)(lds + MISC_OFF);
    if (threadIdx.x < 64) MISC[threadIdx.x] = 0u;
    __syncthreads();
    XcdBarrier bar; bar.bar = (unsigned*)(a.ws + WS_CTL) + CW_BAR; bar.x = 0; bar.st = MISC + 8; bar.w0 = wave_s == 0 ? 1u : 0u;
    if (hi - lo > 1) { bar = xcd_barrier_post((unsigned*)(a.ws + WS_CTL) + CW_BAR, MISC + 8); bar.w0 = wave_s == 0 ? 1u : 0u; }
    if (IN(0)) { { TIDX(); for (int s = blockIdx.x; s < 2 * (NUP / 32); s += gridDim.x) prep_wup_strip(a, lds, s, tid, wave_s); __syncthreads(); }
                 { TIDX(); phase_prologue(a, lds, tid, lane, wave); } }
    SEAM(0);
    layer_phases<0>(a, bar, lds, lo, hi, wave_s);
    layer_phases<1>(a, bar, lds, lo, hi, wave_s);
}
#undef IN
#undef SEAM

#ifndef N_LAUNCH_MODE
#define N_LAUNCH_MODE 1
#endif
extern "C" void kernel_launch(void* const* d_in, const int* in_sizes, int n_in, void* d_out, int out_size, void* d_ws, size_t ws_size, hipStream_t stream) {
    static int grid = 0;
    if (grid == 0) {
        if (n_in != 21 || out_size != NB * SEQ * DM || ws_size < WS_END) { fprintf(stderr, "kernel_launch: unexpected shapes (n_in %d, out %d, ws %zu, need %zu)\n", n_in, out_size, ws_size, (size_t)WS_END); grid = -1; return; }
        int dev = 0, cus = 0;
        if (hipGetDevice(&dev) != hipSuccess || hipDeviceGetAttribute(&cus, hipDeviceAttributeMultiprocessorCount, dev) != hipSuccess || cus <= 0) { grid = -1; return; }
        if (hipFuncSetAttribute((const void*)fwd, hipFuncAttributeMaxDynamicSharedMemorySize, LDS_BYTES) != hipSuccess) { fprintf(stderr, "kernel_launch: hipFuncSetAttribute failed\n"); grid = -1; return; }
        int per_cu = 0;
        if (hipOccupancyMaxActiveBlocksPerMultiprocessor(&per_cu, (const void*)fwd, 512, LDS_BYTES) != hipSuccess || per_cu < 1) fprintf(stderr, "kernel_launch: occupancy query reports %d\n", per_cu);
        (void)hipGetLastError();
        grid = cus;
    }
    if (grid < 0) return;
    (void)hipMemsetAsync((char*)d_ws + WS_CTL, 0, CTL_ZERO_BYTES, stream);
    Args a{};
    for (int i = 0; i < 21; ++i) a.in[i] = (const float*)d_in[i];
    a.out = (float*)d_out; a.ws = (unsigned char*)d_ws;
#if N_LAUNCH_MODE == 1
    a.ph_lo = 0; a.ph_hi = NPHASES;
    hipLaunchKernelGGL(fwd, dim3(grid), dim3(512), LDS_BYTES, stream, a);
#else
    for (int ph = 0; ph < NPHASES; ++ph) { a.ph_lo = ph; a.ph_hi = ph + 1; hipLaunchKernelGGL(fwd, dim3(grid), dim3(512), LDS_BYTES, stream, a); }
#endif
}
```
